# Optimizing an MI355X kernel written in HIP

```python
import math
import jax, jax.numpy as jnp
from jax import lax
import numpy as np

D_MODEL = 2048
BATCH = 8
SEQ = 2048
DEPTH = 2

HEAD_DIM = 64
BLOCK = 128
A_Q_HEADS = 16
A_KV_HEADS = 2
A_GROUP = A_Q_HEADS // A_KV_HEADS
A_WINDOW = 128
B_HEADS = 8
B_PATTERNS = ((128, 1), (512, 4), (2048, 16))
C_HEADS = 16
D_HEADS = 16
D_Q_RANK = 512
D_KV_RANK = 256
D_NOPE = 64
D_ROPE = 32
D_V = 64
ROPE_BASE = 10000.0
D_FF = 4 * D_MODEL
LN_EPS = 1e-5
RMS_EPS = 1e-6
ALPHA = (2 * DEPTH) ** 0.25
BETA = (8 * DEPTH) ** -0.25
N_EVEN = (DEPTH + 1) // 2
N_ODD = DEPTH // 2
A_Q_W = A_Q_HEADS * HEAD_DIM
A_KV_W = A_KV_HEADS * HEAD_DIM
B_W = B_HEADS * HEAD_DIM
EVEN_IN = A_Q_W + 2 * A_KV_W + 3 * B_W * len(B_PATTERNS)
EVEN_OUT = A_Q_W + B_W
C_W = C_HEADS * HEAD_DIM
ODD_IN = 3 * C_W + D_Q_RANK + D_KV_RANK + D_ROPE
ODD_OUT = C_W + D_HEADS * D_V

kernel_name = 'hybrid_swa_dilated_stickbreak_mla_deepnorm'


def layer_norm(x, g, b):
    xf = x.astype(jnp.float32)
    mu = jnp.mean(xf, axis=-1, keepdims=True)
    xc = xf - mu
    var = jnp.mean(xc * xc, axis=-1, keepdims=True)
    y = xc * lax.rsqrt(var + LN_EPS) * g.astype(jnp.float32) + b.astype(jnp.float32)
    return y.astype(x.dtype)


def rms_norm(x, g):
    xf = x.astype(jnp.float32)
    y = xf * lax.rsqrt(jnp.mean(xf * xf, axis=-1, keepdims=True) + RMS_EPS) * g.astype(jnp.float32)
    return y.astype(x.dtype)


def alibi_slopes(n):
    return 2.0 ** (-8.0 * jnp.arange(1, n + 1, dtype=jnp.float32) / n)


def banded_attention(q, k, v, n_back, dist_scale, slopes, sinks=None):
    bsz, n, kh, g, dh = q.shape
    nb = -(-n // BLOCK)
    n_prev = -(-n_back // BLOCK)
    pad = nb * BLOCK - n
    qb = jnp.pad(q, ((0, 0), (0, pad), (0, 0), (0, 0), (0, 0))).reshape(bsz, nb, BLOCK, kh, g, dh)
    kv_pad = ((0, 0), (n_prev * BLOCK, pad), (0, 0), (0, 0))
    kp = jnp.pad(k, kv_pad).reshape(bsz, nb + n_prev, BLOCK, kh, dh)
    vp = jnp.pad(v, kv_pad).reshape(bsz, nb + n_prev, BLOCK, kh, dh)
    kb = jnp.concatenate([kp[:, p:p + nb] for p in range(n_prev + 1)], axis=2)
    vb = jnp.concatenate([vp[:, p:p + nb] for p in range(n_prev + 1)], axis=2)
    scores = jnp.einsum('bnqkgd,bnskd->bnkgqs', qb, kb).astype(jnp.float32) * (1.0 / math.sqrt(dh))
    n_keys = (n_prev + 1) * BLOCK
    qpos = jnp.arange(BLOCK)
    spos = jnp.arange(n_keys)
    rel = n_prev * BLOCK + qpos[:, None] - spos[None, :]
    key_idx = (jnp.arange(nb)[:, None] - n_prev) * BLOCK + spos[None, :]
    valid = (rel >= 0)[None] & (rel <= n_back)[None] & (key_idx >= 0)[:, None, :]
    bias = -slopes.astype(jnp.float32)[:, :, None, None] * (rel * dist_scale).astype(jnp.float32)
    scores = jnp.where(valid[None, :, None, None], scores + bias[None, None], -jnp.inf)
    m = jnp.max(scores, axis=-1)
    if sinks is not None:
        sink = sinks.astype(jnp.float32)[None, None, :, :, None]
        m = jnp.maximum(m, sink)
    p = jnp.exp(scores - m[..., None])
    denom = jnp.sum(p, axis=-1)
    if sinks is not None:
        denom = denom + jnp.exp(sink - m)
    out = jnp.einsum('bnkgqs,bnskd->bnqkgd', p.astype(v.dtype), vb).astype(jnp.float32)
    out = out / jnp.moveaxis(denom, -1, 2)[..., None]
    lse = jnp.moveaxis(m + jnp.log(denom), -1, 2)
    out = out.reshape(bsz, nb * BLOCK, kh, g, dh)[:, :n].astype(q.dtype)
    lse = lse.reshape(bsz, nb * BLOCK, kh, g)[:, :n]
    return out, lse


def to_strided(t, d):
    b, s = t.shape[:2]
    rest = t.shape[2:]
    t = jnp.moveaxis(t.reshape(b, s // d, d, *rest), 2, 1)
    return t.reshape(b * d, s // d, *rest)


def from_strided(t, b):
    bd, n = t.shape[:2]
    d = bd // b
    rest = t.shape[2:]
    t = jnp.moveaxis(t.reshape(b, d, n, *rest), 1, 2)
    return t.reshape(b, n * d, *rest)


def even_mixer(x, w_in, sinks, w_out):
    bsz, seq, _ = x.shape
    h = jnp.einsum('bsd,de->bse', x, w_in)
    qa, ka, va, hb = jnp.split(h, [A_Q_W, A_Q_W + A_KV_W, A_Q_W + 2 * A_KV_W], axis=-1)
    qa = qa.reshape(bsz, seq, A_KV_HEADS, A_GROUP, HEAD_DIM)
    ka = ka.reshape(bsz, seq, A_KV_HEADS, HEAD_DIM)
    va = va.reshape(bsz, seq, A_KV_HEADS, HEAD_DIM)
    oa, _ = banded_attention(qa, ka, va, A_WINDOW - 1, 1,
                             alibi_slopes(A_Q_HEADS).reshape(A_KV_HEADS, A_GROUP),
                             sinks.reshape(A_KV_HEADS, A_GROUP))
    slopes_b = alibi_slopes(B_HEADS).reshape(B_HEADS, 1)
    outs, lses = [], []
    for gi, (window, dil) in enumerate(B_PATTERNS):
        blk = hb[..., gi * 3 * B_W:(gi + 1) * 3 * B_W].reshape(bsz, seq, 3, B_HEADS, HEAD_DIM)
        qb, kb, vb = blk[:, :, 0], blk[:, :, 1], blk[:, :, 2]
        o, lse = banded_attention(to_strided(qb[:, :, :, None], dil), to_strided(kb, dil),
                                  to_strided(vb, dil), window // dil, dil, slopes_b)
        outs.append(from_strided(o[:, :, :, 0], bsz))
        lses.append(from_strided(lse[:, :, :, 0], bsz))
    mix = jax.nn.softmax(jnp.stack(lses), axis=0)
    ob = jnp.einsum('gbsh,gbshd->bshd', mix, jnp.stack(outs).astype(jnp.float32)).astype(x.dtype)
    y = jnp.concatenate([oa.reshape(bsz, seq, A_Q_W), ob.reshape(bsz, seq, B_W)], axis=-1)
    return jnp.einsum('bse,ed->bsd', y, w_out)


def stick_breaking_attention(q, k, v):
    bsz, seq, nh, dh = q.shape
    scale = 1.0 / math.sqrt(dh)
    outs = []
    for i in range(seq // BLOCK):
        lo, hi = i * BLOCK, (i + 1) * BLOCK
        z = jnp.einsum('bqhd,bshd->bhqs', q[:, lo:hi], k[:, :hi]).astype(jnp.float32) * scale
        strict = jnp.arange(hi)[None, :] < (lo + jnp.arange(BLOCK))[:, None]
        log_beta = jax.nn.log_sigmoid(z)
        log_keep = jnp.where(strict, jax.nn.log_sigmoid(-z), 0.0)
        after = lax.cumsum(log_keep, axis=3, reverse=True) - log_keep
        w = jnp.where(strict, jnp.exp(log_beta + after), 0.0)
        outs.append(jnp.einsum('bhqs,bshd->bqhd', w.astype(v.dtype), v[:, :hi]))
    return jnp.concatenate(outs, axis=1)


def apply_rope(x, cos, sin):
    half = x.shape[-1] // 2
    shape = (1, cos.shape[0]) + (1,) * (x.ndim - 3) + (half,)
    c = cos.reshape(shape).astype(x.dtype)
    s = sin.reshape(shape).astype(x.dtype)
    x1, x2 = x[..., :half], x[..., half:]
    return jnp.concatenate([x1 * c - x2 * s, x1 * s + x2 * c], axis=-1)


def mla_attention(q_nope, q_rope, k_nope, k_rope, v):
    seq = q_nope.shape[1]
    scale = 1.0 / math.sqrt(D_NOPE + D_ROPE)
    outs = []
    for i in range(seq // BLOCK):
        lo, hi = i * BLOCK, (i + 1) * BLOCK
        s = (jnp.einsum('bqhd,bshd->bhqs', q_nope[:, lo:hi], k_nope[:, :hi]).astype(jnp.float32)
             + jnp.einsum('bqhr,bsr->bhqs', q_rope[:, lo:hi], k_rope[:, :hi]).astype(jnp.float32)) * scale
        causal = jnp.arange(hi)[None, :] <= (lo + jnp.arange(BLOCK))[:, None]
        p = jax.nn.softmax(jnp.where(causal, s, -jnp.inf), axis=-1)
        outs.append(jnp.einsum('bhqs,bshd->bqhd', p.astype(v.dtype), v[:, :hi]))
    return jnp.concatenate(outs, axis=1)


def odd_mixer(x, w_in, q_norm_g, kv_norm_g, w_uq, w_ukv, w_out):
    bsz, seq, _ = x.shape
    h = jnp.einsum('bsd,de->bse', x, w_in)
    qc, kc, vc, cq, ckv, kr = jnp.split(
        h, [C_W, 2 * C_W, 3 * C_W, 3 * C_W + D_Q_RANK, 3 * C_W + D_Q_RANK + D_KV_RANK], axis=-1)
    oc = stick_breaking_attention(qc.reshape(bsz, seq, C_HEADS, HEAD_DIM),
                                  kc.reshape(bsz, seq, C_HEADS, HEAD_DIM),
                                  vc.reshape(bsz, seq, C_HEADS, HEAD_DIM))
    q = jnp.einsum('bsr,re->bse', rms_norm(cq, q_norm_g), w_uq).reshape(bsz, seq, D_HEADS, D_NOPE + D_ROPE)
    kv = jnp.einsum('bsr,re->bse', rms_norm(ckv, kv_norm_g), w_ukv).reshape(bsz, seq, D_HEADS, D_NOPE + D_V)
    q_nope, q_rope = q[..., :D_NOPE], q[..., D_NOPE:]
    k_nope, v = kv[..., :D_NOPE], kv[..., D_NOPE:]
    inv_freq = ROPE_BASE ** (-jnp.arange(0, D_ROPE, 2, dtype=jnp.float32) / D_ROPE)
    ang = jnp.arange(seq, dtype=jnp.float32)[:, None] * inv_freq[None, :]
    cos, sin = jnp.cos(ang), jnp.sin(ang)
    od = mla_attention(q_nope, apply_rope(q_rope, cos, sin), k_nope, apply_rope(kr, cos, sin), v)
    y = jnp.concatenate([oc.reshape(bsz, seq, C_W), od.reshape(bsz, seq, D_HEADS * D_V)], axis=-1)
    return jnp.einsum('bse,ed->bsd', y, w_out)


def sqrelu_mlp(x, w1, w2):
    hid = jax.nn.relu(jnp.einsum('bsd,df->bsf', x, w1))
    return jnp.einsum('bsf,fd->bsd', hid * hid, w2)


def setup_inputs(seed: int = 0) -> dict:
    key = jax.random.key(seed)
    ks = jax.random.split(key, 16)
    f32 = jnp.float32

    def normal(k, shape, scale):
        return jax.random.normal(k, shape, f32) * scale

    x = normal(ks[0], (BATCH, SEQ, D_MODEL), 1.0)
    b_group_col = jnp.concatenate([jnp.ones(2 * B_W, f32), jnp.full((B_W,), BETA, f32)])
    even_col = jnp.concatenate([jnp.ones(A_Q_W + A_KV_W, f32), jnp.full((A_KV_W,), BETA, f32)]
                               + [b_group_col] * len(B_PATTERNS))
    even_w_in = normal(ks[1], (N_EVEN, D_MODEL, EVEN_IN), D_MODEL ** -0.5) * even_col
    even_sinks = 1.0 + normal(ks[2], (N_EVEN, A_Q_HEADS), 1.0)
    even_w_out = normal(ks[3], (N_EVEN, EVEN_OUT, D_MODEL), BETA * EVEN_OUT ** -0.5)
    odd_col = jnp.concatenate([jnp.ones(2 * C_W, f32), jnp.full((C_W,), BETA, f32),
                               jnp.ones(D_Q_RANK + D_KV_RANK + D_ROPE, f32)])
    odd_w_in = normal(ks[4], (N_ODD, D_MODEL, ODD_IN), D_MODEL ** -0.5) * odd_col
    odd_q_norm_g = 1.0 + normal(ks[5], (N_ODD, D_Q_RANK), 0.02)
    odd_kv_norm_g = 1.0 + normal(ks[6], (N_ODD, D_KV_RANK), 0.02)
    odd_w_uq = normal(ks[7], (N_ODD, D_Q_RANK, D_HEADS * (D_NOPE + D_ROPE)), D_Q_RANK ** -0.5)
    ukv_col = jnp.tile(jnp.concatenate([jnp.ones(D_NOPE, f32), jnp.full((D_V,), BETA, f32)]), D_HEADS)
    odd_w_ukv = normal(ks[8], (N_ODD, D_KV_RANK, D_HEADS * (D_NOPE + D_V)), D_KV_RANK ** -0.5) * ukv_col
    odd_w_out = normal(ks[9], (N_ODD, ODD_OUT, D_MODEL), BETA * ODD_OUT ** -0.5)
    ln1_g = 1.0 + normal(ks[10], (DEPTH, D_MODEL), 0.02)
    ln1_b = normal(ks[11], (DEPTH, D_MODEL), 0.02)
    mlp_w1 = normal(ks[12], (DEPTH, D_MODEL, D_FF), D_MODEL ** -0.5)
    mlp_w2 = normal(ks[13], (DEPTH, D_FF, D_MODEL), BETA * D_FF ** -0.5)
    ln2_g = 1.0 + normal(ks[14], (DEPTH, D_MODEL), 0.02)
    ln2_b = normal(ks[15], (DEPTH, D_MODEL), 0.02)
    return {'x': x, 'even_w_in': even_w_in, 'even_sinks': even_sinks, 'even_w_out': even_w_out,
            'odd_w_in': odd_w_in, 'odd_q_norm_g': odd_q_norm_g, 'odd_kv_norm_g': odd_kv_norm_g,
            'odd_w_uq': odd_w_uq, 'odd_w_ukv': odd_w_ukv, 'odd_w_out': odd_w_out,
            'ln1_g': ln1_g, 'ln1_b': ln1_b, 'mlp_w1': mlp_w1, 'mlp_w2': mlp_w2,
            'ln2_g': ln2_g, 'ln2_b': ln2_b}


def reference(x, even_w_in, even_sinks, even_w_out, odd_w_in, odd_q_norm_g, odd_kv_norm_g,
              odd_w_uq, odd_w_ukv, odd_w_out, ln1_g, ln1_b, mlp_w1, mlp_w2, ln2_g, ln2_b):
    for layer in range(DEPTH):
        j = layer // 2
        if layer % 2 == 0:
            mixed = even_mixer(x, even_w_in[j], even_sinks[j], even_w_out[j])
        else:
            mixed = odd_mixer(x, odd_w_in[j], odd_q_norm_g[j], odd_kv_norm_g[j],
                              odd_w_uq[j], odd_w_ukv[j], odd_w_out[j])
        x = layer_norm(ALPHA * x + mixed, ln1_g[layer], ln1_b[layer])
        x = layer_norm(ALPHA * x + sqrelu_mlp(x, mlp_w1[layer], mlp_w2[layer]), ln2_g[layer], ln2_b[layer])
    return x
```

```cpp
#include <hip/hip_runtime.h>
#include <hip/hip_cooperative_groups.h>
#include <cstdio>
#include <cstdint>
#include <cmath>
namespace cg = cooperative_groups;
#ifndef WGM_N2048
#define WGM_N2048 4
#endif
#ifndef WGM_UP
#define WGM_UP 4
#endif
#ifndef WGM_IN
#define WGM_IN 4
#endif
#ifndef WGM_SMALL
#define WGM_SMALL 4
#endif
namespace pg8 {
#define PG8_LAS __attribute__((address_space(3)))
typedef unsigned short bf16_t;
typedef _Float16 bf16x8 __attribute__((ext_vector_type(8)));
typedef float f32x4 __attribute__((ext_vector_type(4)));
typedef unsigned u32x4 __attribute__((ext_vector_type(4)));
constexpr int BM = 256, BK = 64, HALF = 128, HTB = HALF * BK * 2  , STAGE_BYTES = 8 * HTB, NXCD = 8, WGM = 8;

__host__ __device__ __forceinline__ int lds_byte(int r, int c) { const int st = (r >> 4) * 2 + (c >> 5), rr = r & 15, cc = c & 31, ob = rr * 64 + cc * 2; return st * 1024 + (ob ^ (((ob >> 9) & 1) << 5)); }
__host__ __device__ __forceinline__ void stage_rc(int b, int& R, int& C) { const int st = b / 1024, sb = b % 1024, swz = sb ^ (((sb >> 9) & 1) << 5); R = (st >> 1) * 16 + swz / 64; C = (st & 1) * 32 + (swz % 64) / 2; }
__host__ __device__ __forceinline__ int perm32(int rho) { const int n = rho >> 4, i = rho & 15; return 8 * (i >> 2) + 4 * n + (i & 3); }

struct Unit { int pm, pn; };
struct Gemm { const bf16_t* A; const bf16_t* Bt; int M, N, K; };

struct StaticOrder {
    int nM, nN, nwg, G, c, wgm, flip;
    __host__ __device__ void init(int M, int N, int G_, int c_, int wgm_ = 4, int flip_ = 0) { nM = M / BM; nN = N / BM; nwg = nM * nN; G = G_; c = c_; wgm = wgm_; flip = flip_; }
    __host__ __device__ bool next(int i, Unit& u) const {
        const long L = (long)i * G + c; if (L >= nwg) return false;
        int wgid = (int)L; { const int q = nwg / NXCD, r = nwg % NXCD, xcd = wgid % NXCD, off = wgid / NXCD; wgid = (xcd < r ? xcd * (q + 1) : r * (q + 1) + (xcd - r) * q) + off; }
        const int nig = wgm * nN, gid = wgid / nig, fm = gid * wgm, gsz = (nM - fm) < wgm ? (nM - fm) : wgm;
        u.pm = (fm + ((wgid % nig) % gsz)) ^ flip; u.pn = (wgid % nig) / gsz; return true;
    }
    __device__ __forceinline__ void a_ready(const Unit&) const {}
    __device__ __forceinline__ void done(const Unit&) const {}
};


typedef unsigned u32x2 __attribute__((ext_vector_type(2)));
__device__ __forceinline__ unsigned pk16(float lo, float hi) {
    typedef _Float16 h2_t __attribute__((ext_vector_type(2)));
    h2_t v; v.x = (_Float16)lo; v.y = (_Float16)hi; return __builtin_bit_cast(unsigned, v);
}
template <int KIND, int F> struct EpiAny {
    static constexpr bool AFTER_DRAIN = false; static constexpr int kind = KIND; static constexpr bool perm = (KIND <= 2);
    bf16_t* O; int ldc;
    const float* base; float* out; float alpha;
    const float* rope;
    const float* st_in; float* st_out;
    bf16_t* xb; const bf16_t* xbase;
    const float* g; const float* b;
    const float* c1; const float* c2;
    __device__ __forceinline__ void row_stats(int row, float& mean, float& rstd) const {
        const float s1 = st_in[2 * row], s2 = st_in[2 * row + 1]; mean = s1 * (1.f / 2048.f);
        const float var = fmaxf(s2 * (1.f / 2048.f) - mean * mean, 0.f); rstd = __builtin_amdgcn_rsqf(var + 1e-5f); }
    __device__ __forceinline__ void operator()(const f32x4 (&acc)[2][2][4][2], const Unit& u, int wr, int wc, int fr, int fq) const {
        const int row0 = u.pm * BM + wr * 64 + fr;
        if (kind <= 1) {
            const int col0 = u.pn * BM + wc * 32 + 8 * fq;
            f32x4 c1v[2][2], c2v[2][2];
            if (F == 1) {
#pragma unroll
                for (int bj = 0; bj < 2; ++bj)
#pragma unroll
                    for (int n = 0; n < 2; ++n) { c1v[bj][n] = *(const f32x4*)(c1 + col0 + bj * HALF + 4 * n); c2v[bj][n] = *(const f32x4*)(c2 + col0 + bj * HALF + 4 * n); } }
            float mean8[2][4], rstd8[2][4];
#pragma unroll
            for (int ai = 0; ai < 2; ++ai)
#pragma unroll
                for (int m = 0; m < 4; ++m) { mean8[ai][m] = 0.f; rstd8[ai][m] = 1.f; if (F == 1) row_stats(row0 + ai * HALF + m * 16, mean8[ai][m], rstd8[ai][m]); }
#pragma unroll
            for (int ai = 0; ai < 2; ++ai)
#pragma unroll
                for (int m = 0; m < 4; ++m) { const int row = row0 + ai * HALF + m * 16; bf16_t* rowp = O + (size_t)row * ldc + col0;
                    const float mean = mean8[ai][m], rstd = rstd8[ai][m];
#pragma unroll
                    for (int bj = 0; bj < 2; ++bj) { f32x4 v0 = acc[ai][bj][m][0], v1 = acc[ai][bj][m][1];
                        if (F == 1) { v0 = (v0 - c1v[bj][0] * mean) * rstd + c2v[bj][0]; v1 = (v1 - c1v[bj][1] * mean) * rstd + c2v[bj][1]; }
                        if (kind == 1) {
#pragma unroll
                            for (int e = 0; e < 4; ++e) { float a = fmaxf(v0[e], 0.f), b_ = fmaxf(v1[e], 0.f); v0[e] = a * a; v1[e] = b_ * b_; } }
                        u32x4 w; w.x = pk16(v0[0], v0[1]); w.y = pk16(v0[2], v0[3]); w.z = pk16(v1[0], v1[1]); w.w = pk16(v1[2], v1[3]);
                        *(u32x4*)(rowp + bj * HALF) = w; } }
        } else if (kind == 2) {
            const int col0 = u.pn * BM + wc * 32 + 8 * fq;
            typedef _Float16 h8_t __attribute__((ext_vector_type(8)));
#pragma unroll
            for (int ai = 0; ai < 2; ++ai) {
                f32x4 gv[2][2], bv[2][2];
#pragma unroll
                for (int bj = 0; bj < 2; ++bj)
#pragma unroll
                    for (int n = 0; n < 2; ++n) { gv[bj][n] = (f32x4){1.f, 1.f, 1.f, 1.f}; bv[bj][n] = (f32x4){0.f, 0.f, 0.f, 0.f};
                        if (F >= 1) { gv[bj][n] = *(const f32x4*)(g + col0 + bj * HALF + 4 * n); bv[bj][n] = *(const f32x4*)(b + col0 + bj * HALF + 4 * n); } }
#pragma unroll
              for (int mp = 0; mp < 2; ++mp) {
                h8_t hb[4][2]; float mean4[4], rstd4[4];
#pragma unroll
                for (int m = 2 * mp; m < 2 * mp + 2; ++m) { const int row = row0 + ai * HALF + m * 16; const size_t off = (size_t)row * ldc + col0;
                    mean4[m] = 0.f; rstd4[m] = 1.f; if (F >= 1) row_stats(row, mean4[m], rstd4[m]);
#pragma unroll
                    for (int bj = 0; bj < 2; ++bj) hb[m][bj] = *(const h8_t*)(xbase + off + bj * HALF); }
#pragma unroll
                for (int m = 2 * mp; m < 2 * mp + 2; ++m) { const int row = row0 + ai * HALF + m * 16; const size_t off = (size_t)row * ldc + col0;
                    const float mean = mean4[m], rstd = rstd4[m];
                    float s1 = 0.f, s2 = 0.f;
#pragma unroll
                    for (int bj = 0; bj < 2; ++bj) { const size_t o2 = off + bj * HALF; const h8_t hv = hb[m][bj];
                        f32x4 b0 = (f32x4){(float)hv[0], (float)hv[1], (float)hv[2], (float)hv[3]}, b1 = (f32x4){(float)hv[4], (float)hv[5], (float)hv[6], (float)hv[7]};
                        if (F >= 1) { b0 = (b0 - mean) * rstd * gv[bj][0] + bv[bj][0]; b1 = (b1 - mean) * rstd * gv[bj][1] + bv[bj][1]; }
                        const f32x4 r0 = b0 * alpha + acc[ai][bj][m][0], r1 = b1 * alpha + acc[ai][bj][m][1];
                        if (F <= 1 || F == 3) { u32x4 w; w.x = pk16(r0[0], r0[1]); w.y = pk16(r0[2], r0[3]); w.z = pk16(r1[0], r1[1]); w.w = pk16(r1[2], r1[3]); *(u32x4*)(xb + o2) = w;
                            s1 += ((r0[0] + r0[1]) + (r0[2] + r0[3])) + ((r1[0] + r1[1]) + (r1[2] + r1[3]));
                            s2 += ((r0[0] * r0[0] + r0[1] * r0[1]) + (r0[2] * r0[2] + r0[3] * r0[3])) + ((r1[0] * r1[0] + r1[1] * r1[1]) + (r1[2] * r1[2] + r1[3] * r1[3])); }
                        else { *(f32x4*)(out + o2) = r0; *(f32x4*)(out + o2 + 4) = r1; } }
                    if (F <= 1) { s1 += __shfl_xor(s1, 16); s2 += __shfl_xor(s2, 16); s1 += __shfl_xor(s1, 32); s2 += __shfl_xor(s2, 32);
                        if (fq == 0) { __hip_atomic_fetch_add(st_out + 2 * row, s1, __ATOMIC_RELAXED, __HIP_MEMORY_SCOPE_AGENT); __hip_atomic_fetch_add(st_out + 2 * row + 1, s2, __ATOMIC_RELAXED, __HIP_MEMORY_SCOPE_AGENT); } } }
                asm volatile("" ::: "memory"); } }
        } else {
            f32x4 rc[2][4], rs[2][4];
#pragma unroll
            for (int ai = 0; ai < 2; ++ai)
#pragma unroll
                for (int m = 0; m < 4; ++m) { const int pos = (row0 + ai * HALF + m * 16) & 2047; rc[ai][m] = *(const f32x4*)(rope + pos * 32 + 4 * fq); rs[ai][m] = *(const f32x4*)(rope + pos * 32 + 16 + 4 * fq); }
#pragma unroll
            for (int ai = 0; ai < 2; ++ai)
#pragma unroll
                for (int m = 0; m < 4; ++m) { const int row = row0 + ai * HALF + m * 16;
#pragma unroll
                    for (int bj = 0; bj < 2; ++bj) { const int gb = u.pn * BM + bj * HALF + wc * 32; f32x4 a = acc[ai][bj][m][0], b_ = acc[ai][bj][m][1];
                        if (((gb >> 5) % 3) == 2) { const f32x4 c = rc[ai][m], s = rs[ai][m];
                            const f32x4 a2 = a * c - b_ * s, b2 = a * s + b_ * c; a = a2; b_ = b2; }
                        bf16_t* p = O + (size_t)row * ldc + gb + 4 * fq;
                        u32x2 w0, w1; w0.x = pk16(a[0], a[1]); w0.y = pk16(a[2], a[3]); w1.x = pk16(b_[0], b_[1]); w1.y = pk16(b_[2], b_[3]);
                        *(u32x2*)p = w0; *(u32x2*)(p + 16) = w1; }
                    asm volatile("" ::: "memory"); }
        }
    }
};

template <class Epi, class Sched, bool ALIGN_EPI = false, bool SP2 = false>
__device__ __forceinline__ void gemm_phase(PG8_LAS unsigned char* lds, const Gemm g, const Sched& S, const Epi& E) {
    int tid_ = threadIdx.x; asm volatile("" : "+v"(tid_));
    const int tid = tid_, wid = __builtin_amdgcn_readfirstlane(tid >> 6), lane = tid & 63, wr = wid >> 2, wc = wid & 3, fr = lane & 15, fq = lane >> 4;
    const int K = g.K, nt = K / BK;
    unsigned voffA[2], voffB[2];
#pragma unroll
    for (int i = 0; i < 2; ++i) { int R, C; stage_rc(tid * 16 + i * 8192, R, C); const int Rb = E.perm ? ((R & ~31) + perm32(R & 31)) : R;
        voffA[i] = (unsigned)(R * K + C) * 2u; voffB[i] = (unsigned)(Rb * K + C) * 2u; }
    const size_t kstep = (size_t)(BK * 2);
    const size_t hstep = (size_t)HALF * K * 2;
    const size_t tstep = 2 * hstep;
    const unsigned ldsw = (unsigned)wid * 1024u;
    const int aoff = lds_byte(wr * 64 + fr, fq * 8), boff = lds_byte(wc * 32 + fr, fq * 8);
#define PG8_SA(b, h) (((b) * 2 + (h)) * HTB)
#define PG8_SB(b, h) ((4 + (b) * 2 + (h)) * HTB)
#define PG8_STAGE(bufoff, gbase, voff) do { _Pragma("unroll") for (int _i = 0; _i < 2; ++_i) \
        __builtin_amdgcn_global_load_lds((const unsigned*)((const char*)(gbase) + (voff)[_i]), (PG8_LAS unsigned*)(lds + (bufoff) + ldsw + _i * 8192), 16, 0, 0); } while (0)
#define PG8_LDA(dst, b, h) do { _Pragma("unroll") for (int m = 0; m < 4; ++m) _Pragma("unroll") for (int k = 0; k < 2; ++k) dst[m][k] = *(const PG8_LAS bf16x8*)(lds + PG8_SA(b, h) + aoff + m * 2048 + k * 1024); } while (0)
#define PG8_LDB(dst, b, h) do { _Pragma("unroll") for (int n = 0; n < 2; ++n) _Pragma("unroll") for (int k = 0; k < 2; ++k) dst[n][k] = *(const PG8_LAS bf16x8*)(lds + PG8_SB(b, h) + boff + n * 2048 + k * 1024); } while (0)
#define PG8_MMA(ai, bj, At, Bt) do { __builtin_amdgcn_s_setprio(1); _Pragma("unroll") for (int m = 0; m < 4; ++m) _Pragma("unroll") for (int n = 0; n < 2; ++n) _Pragma("unroll") for (int k = 0; k < 2; ++k) \
        acc[ai][bj][m][n] = __builtin_amdgcn_mfma_f32_16x16x32_f16(Bt[n][k], At[m][k], acc[ai][bj][m][n], 0, 0, 0); __builtin_amdgcn_s_setprio(0); } while (0)
#define PG8_WAIT_V(n) asm volatile("s_waitcnt vmcnt(" #n ")" ::: "memory")
#define PG8_WAIT_L(n) asm volatile("s_waitcnt lgkmcnt(" #n ")" ::: "memory")
#define PG8_BAR __builtin_amdgcn_s_barrier()
#define PG8_SCHED __builtin_amdgcn_sched_barrier(0)
    Unit cur, nxt; int ui = 0;
    if (!S.next(0, cur)) return;
    f32x4 acc[2][2][4][2];
#pragma unroll
    for (int a = 0; a < 2; ++a)
#pragma unroll
        for (int b = 0; b < 2; ++b)
#pragma unroll
            for (int m = 0; m < 4; ++m)
#pragma unroll
                for (int n = 0; n < 2; ++n) acc[a][b][m][n] = (f32x4){0.f, 0.f, 0.f, 0.f};
    bf16x8 At[4][2], B0[2][2], B1[2][2];
    const char* cA = (const char*)g.A + (size_t)cur.pm * tstep; const char* cB = (const char*)g.Bt + (size_t)cur.pn * tstep;
    S.a_ready(cur);
    if constexpr (SP2) {
        PG8_STAGE(PG8_SB(0, 0), cB, voffB); PG8_STAGE(PG8_SB(0, 1), cB + hstep, voffB); PG8_STAGE(PG8_SA(0, 0), cA, voffA); PG8_STAGE(PG8_SA(0, 1), cA + hstep, voffA);
        if (wr == 1) PG8_BAR;
        PG8_WAIT_V(2); PG8_BAR;
        PG8_STAGE(PG8_SB(1, 0), cB + kstep, voffB); PG8_STAGE(PG8_SA(1, 0), cA + kstep, voffA); PG8_STAGE(PG8_SB(1, 1), cB + hstep + kstep, voffB);
        PG8_WAIT_V(6); PG8_BAR;
    } else {
        PG8_STAGE(PG8_SB(0, 0), cB, voffB); PG8_STAGE(PG8_SA(0, 0), cA, voffA); PG8_STAGE(PG8_SB(0, 1), cB + hstep, voffB); PG8_STAGE(PG8_SA(0, 1), cA + hstep, voffA);
        if (wr == 1) PG8_BAR;
        PG8_WAIT_V(4); PG8_BAR;
        PG8_STAGE(PG8_SB(1, 0), cB + kstep, voffB); PG8_STAGE(PG8_SA(1, 0), cA + kstep, voffA); PG8_STAGE(PG8_SB(1, 1), cB + hstep + kstep, voffB);
        PG8_WAIT_V(6); PG8_BAR;
    }
    for (;;) {
        const bool has_next = S.next(ui + 1, nxt);
        const char* nA = has_next ? (const char*)g.A + (size_t)nxt.pm * tstep : cA; const char* nB = has_next ? (const char*)g.Bt + (size_t)nxt.pn * tstep : cB;
        for (int t = 0; t < nt; t += 2) {
            const bool last = (t == nt - 2);
            const char* a1 = cA + (size_t)(t + 1) * kstep;
            const char* a2 = last ? nA : cA + (size_t)(t + 2) * kstep; const char* b2 = last ? nB : cB + (size_t)(t + 2) * kstep;
            const char* a3 = a2 + kstep; const char* b3 = b2 + kstep;
            if (last && has_next) S.a_ready(nxt);
            if constexpr (SP2) {
            PG8_LDB(B0, 0, 0); PG8_LDB(B1, 0, 1); PG8_SCHED; PG8_LDA(At, 0, 0); PG8_STAGE(PG8_SA(1, 1), a1 + hstep, voffA);
            PG8_WAIT_V(8); PG8_WAIT_L(0); PG8_BAR; PG8_MMA(0, 0, At, B0); PG8_MMA(0, 1, At, B1); PG8_BAR; PG8_SCHED;
            PG8_LDA(At, 0, 1); PG8_STAGE(PG8_SB(0, 0), b2, voffB); PG8_STAGE(PG8_SB(0, 1), b2 + hstep, voffB); PG8_STAGE(PG8_SA(0, 0), a2, voffA);
            PG8_WAIT_V(8); PG8_WAIT_L(0); PG8_BAR; PG8_MMA(1, 0, At, B0); PG8_MMA(1, 1, At, B1); PG8_BAR; PG8_SCHED;
            PG8_LDB(B0, 1, 0); PG8_LDB(B1, 1, 1); PG8_SCHED; PG8_LDA(At, 1, 0); PG8_STAGE(PG8_SA(0, 1), a2 + hstep, voffA);
            PG8_WAIT_V(8); PG8_WAIT_L(0); PG8_BAR; PG8_MMA(0, 0, At, B0); PG8_MMA(0, 1, At, B1); PG8_BAR; PG8_SCHED;
            PG8_LDA(At, 1, 1); PG8_STAGE(PG8_SB(1, 0), b3, voffB); PG8_STAGE(PG8_SB(1, 1), b3 + hstep, voffB); PG8_STAGE(PG8_SA(1, 0), a3, voffA);
            PG8_WAIT_V(8); PG8_WAIT_L(0); PG8_BAR; PG8_MMA(1, 0, At, B0); PG8_MMA(1, 1, At, B1); PG8_BAR; PG8_SCHED;
            } else {
            PG8_LDB(B0, 0, 0); PG8_SCHED; PG8_LDA(At, 0, 0); PG8_STAGE(PG8_SA(1, 1), a1 + hstep, voffA);
            PG8_WAIT_L(8); PG8_BAR; PG8_WAIT_L(0); PG8_MMA(0, 0, At, B0); PG8_BAR; PG8_SCHED;
            PG8_LDB(B1, 0, 1); PG8_STAGE(PG8_SB(0, 0), b2, voffB);
            PG8_BAR; PG8_WAIT_L(0); PG8_MMA(0, 1, At, B1); PG8_BAR;
            PG8_LDA(At, 0, 1); PG8_STAGE(PG8_SA(0, 0), a2, voffA);
            PG8_BAR; PG8_WAIT_L(0); PG8_MMA(1, 0, At, B0); PG8_BAR; PG8_SCHED;
            PG8_STAGE(PG8_SB(0, 1), b2 + hstep, voffB);
            PG8_WAIT_V(6); PG8_BAR; PG8_MMA(1, 1, At, B1); PG8_BAR;
            PG8_LDB(B0, 1, 0); PG8_SCHED; PG8_LDA(At, 1, 0); PG8_STAGE(PG8_SA(0, 1), a2 + hstep, voffA);
            PG8_WAIT_L(8); PG8_BAR; PG8_WAIT_L(0); PG8_MMA(0, 0, At, B0); PG8_BAR; PG8_SCHED;
            PG8_LDB(B1, 1, 1); PG8_STAGE(PG8_SB(1, 0), b3, voffB);
            PG8_BAR; PG8_WAIT_L(0); PG8_MMA(0, 1, At, B1); PG8_BAR;
            PG8_LDA(At, 1, 1); PG8_STAGE(PG8_SA(1, 0), a3, voffA);
            PG8_BAR; PG8_WAIT_L(0); PG8_MMA(1, 0, At, B0); PG8_BAR; PG8_SCHED;
            PG8_STAGE(PG8_SB(1, 1), b3 + hstep, voffB);
            PG8_WAIT_V(6); PG8_BAR; PG8_MMA(1, 1, At, B1); PG8_BAR;
            }
        }
        if constexpr (ALIGN_EPI) { if (wr == 0) PG8_BAR; }
        if constexpr (!Epi::AFTER_DRAIN) { E(acc, cur, wr, wc, fr, fq); S.done(cur); }
        if (!has_next) break;
#pragma unroll
        for (int a = 0; a < 2; ++a)
#pragma unroll
            for (int b = 0; b < 2; ++b)
#pragma unroll
                for (int m = 0; m < 4; ++m)
#pragma unroll
                    for (int n = 0; n < 2; ++n) acc[a][b][m][n] = (f32x4){0.f, 0.f, 0.f, 0.f};
        cur = nxt; cA = nA; cB = nB; ++ui;
        if constexpr (ALIGN_EPI) { if (wr == 1) PG8_BAR; }
    }
    PG8_WAIT_V(0);
    if constexpr (!ALIGN_EPI) { if (wr == 0) PG8_BAR; }
    PG8_BAR;
    if constexpr (Epi::AFTER_DRAIN) { E.fused(acc, cur, wr, wc, fr, fq, lds, wid, lane); S.done(cur); }
#undef PG8_SA
#undef PG8_SB
#undef PG8_STAGE
#undef PG8_LDA
#undef PG8_LDB
#undef PG8_MMA
#undef PG8_WAIT_V
#undef PG8_WAIT_L
#undef PG8_BAR
#undef PG8_SCHED
}
}

#define LAS __attribute__((address_space(3)))
typedef unsigned short h16;
typedef _Float16 h8 __attribute__((ext_vector_type(8)));
typedef _Float16 h4 __attribute__((ext_vector_type(4)));
typedef float f32x4 __attribute__((ext_vector_type(4)));
typedef float f32x16 __attribute__((ext_vector_type(16)));
typedef unsigned u32x4 __attribute__((ext_vector_type(4)));
typedef unsigned u32x2 __attribute__((ext_vector_type(2)));
typedef short v4i16_t __attribute__((ext_vector_type(4)));
using pg8::pk16;

constexpr int SEQ = 2048, DM = 2048, MTOK = 16384, DFF = 8192;
constexpr int EVEN_IN = 5888, EVEN_OUT = 1536, ODD_IN = 3872, ODD_INP = 4096, UQ_N = 1536, UKV_N = 2048;
constexpr float LN_EPS = 1e-5f, RMS_EPS = 1e-6f;
constexpr float ALPHA = 1.41421356237309515f;
constexpr float LOG2E = 1.4426950408889634f, LN2 = 0.6931471805599453f;
constexpr int NWAVES = 8;

constexpr size_t MiB = 1u << 20;
constexpr size_t WS_BAR = 0;
constexpr size_t WS_STATS = 64 * 1024;
constexpr size_t WS_C12 = 512 * 1024;
constexpr size_t WS_ROPE = 1 * MiB;
constexpr size_t WS_W_OIN = 2 * MiB, WS_W_UQ = 18 * MiB, WS_W_UKV = 20 * MiB, WS_W_OOUT = 21 * MiB, WS_W_W1B = 29 * MiB, WS_W_W2B = 61 * MiB;
constexpr size_t WS_W_EIN = 93 * MiB, WS_W_EOUT = 116 * MiB, WS_W_W1A = 122 * MiB, WS_W_W2A = 154 * MiB;
constexpr size_t WS_XB = 186 * MiB;
constexpr size_t WS_HID = 250 * MiB;
constexpr size_t WS_H = WS_HID, WS_Y = WS_HID + 184 * MiB;
constexpr size_t WS_H2 = WS_HID, WS_CQN = WS_HID + 128 * MiB, WS_CKVN = WS_HID + 144 * MiB, WS_KR = WS_HID + 152 * MiB, WS_Q2 = WS_HID + 153 * MiB;
constexpr size_t WS_KV = 93 * MiB;
constexpr size_t WS_Y2 = WS_XB;
constexpr size_t WS_END = 506 * MiB;
constexpr size_t OUT_PO = 0, OUT_LSE = (size_t)3 * MTOK * 512;

struct Params { const float* in[16]; float* out; unsigned char* ws; };

__device__ __forceinline__ float wave_sum(float v) {
#pragma unroll
    for (int o = 1; o < 64; o <<= 1) v += __shfl_xor(v, o);
    return v;
}

__device__ __forceinline__ void transpose_item(const float* W, int K, int N, h16* WT, int item, LAS float* scr, int lane) {
    const int nblk = N / 32, kb = item / nblk, nb = item % nblk, k0 = 64 * kb, n0 = 32 * nb;
#pragma unroll
    for (int i = 0; i < 32; ++i) { const int kk = 2 * i + (lane >> 5); scr[kk * 33 + (lane & 31)] = W[(size_t)(k0 + kk) * N + n0 + (lane & 31)]; }
    asm volatile("s_waitcnt lgkmcnt(0)" ::: "memory");
    const int c = lane & 7;
#pragma unroll
    for (int j = 0; j < 4; ++j) { const int n = (lane >> 3) + 8 * j; const LAS float* s = scr + (8 * c) * 33 + n;
        u32x4 o; o.x = pk16(s[0 * 33], s[1 * 33]); o.y = pk16(s[2 * 33], s[3 * 33]); o.z = pk16(s[4 * 33], s[5 * 33]); o.w = pk16(s[6 * 33], s[7 * 33]);
        *(u32x4*)(WT + (size_t)(n0 + n) * K + k0 + 8 * c) = o; }
    asm volatile("s_waitcnt lgkmcnt(0)" ::: "memory");
}

__device__ __forceinline__ void transpose_item_fold(const float* W, int K, int N, h16* WT, int item, LAS float* scr, int lane, const float* g, const float* b, float* c1, float* c2) {
    const int nblk = N / 32, kb = item / nblk, nb = item % nblk, k0 = 64 * kb, n0 = 32 * nb;
    float a1 = 0.f, a2 = 0.f;
#pragma unroll
    for (int i = 0; i < 32; ++i) { const int kk = 2 * i + (lane >> 5); const float w = W[(size_t)(k0 + kk) * N + n0 + (lane & 31)]; const float wg = w * g[k0 + kk];
        scr[kk * 33 + (lane & 31)] = wg; a1 += (float)(_Float16)wg; a2 += b[k0 + kk] * w; }
    a1 += __shfl_xor(a1, 32); a2 += __shfl_xor(a2, 32);
    if (lane < 32) { __hip_atomic_fetch_add(c1 + n0 + lane, a1, __ATOMIC_RELAXED, __HIP_MEMORY_SCOPE_AGENT); __hip_atomic_fetch_add(c2 + n0 + lane, a2, __ATOMIC_RELAXED, __HIP_MEMORY_SCOPE_AGENT); }
    asm volatile("s_waitcnt lgkmcnt(0)" ::: "memory");
    const int c = lane & 7;
#pragma unroll
    for (int j = 0; j < 4; ++j) { const int n = (lane >> 3) + 8 * j; const LAS float* s = scr + (8 * c) * 33 + n;
        u32x4 o; o.x = pk16(s[0 * 33], s[1 * 33]); o.y = pk16(s[2 * 33], s[3 * 33]); o.z = pk16(s[4 * 33], s[5 * 33]); o.w = pk16(s[6 * 33], s[7 * 33]);
        *(u32x4*)(WT + (size_t)(n0 + n) * K + k0 + 8 * c) = o; }
    asm volatile("s_waitcnt lgkmcnt(0)" ::: "memory");
}

__device__ __forceinline__ void sincos_d(double a, double& s, double& c) {
    const double k = __builtin_rint(a * 0.63661977236758134308);
    const double y = (a - k * 1.57079632679489655800) - k * 6.12323399573676603587e-17;
    const double y2 = y * y;
    double sp = -7.6471637318198164759e-13;
    sp = sp * y2 + 1.6059043836821614599e-10; sp = sp * y2 - 2.5052108385441718775e-08; sp = sp * y2 + 2.7557319223985890653e-06;
    sp = sp * y2 - 1.9841269841269841270e-04; sp = sp * y2 + 8.3333333333333332177e-03; sp = sp * y2 - 1.6666666666666665741e-01;
    const double sy = y + y * y2 * sp;
    double cp = 4.7794773323873852974e-14;
    cp = cp * y2 - 1.1470745597729724714e-11; cp = cp * y2 + 2.0876756987868098979e-09; cp = cp * y2 - 2.7557319223985888276e-07;
    cp = cp * y2 + 2.4801587301587301566e-05; cp = cp * y2 - 1.3888888888888889419e-03; cp = cp * y2 + 4.1666666666666664354e-02; cp = cp * y2 - 0.5;
    const double cy = 1.0 + y2 * cp;
    const int q = ((int)k) & 3;
    s = (q == 0) ? sy : (q == 1) ? cy : (q == 2) ? -sy : -cy;
    c = (q == 0) ? cy : (q == 1) ? -sy : (q == 2) ? -cy : sy;
}

__device__ __forceinline__ void ln_pass(float* R, h16* XB, const float* g, const float* b, bool write_h, int gw, int NGW, int lane) {
    for (int row = gw; row < MTOK; row += NGW) {
        f32x4* rp = (f32x4*)(R + (size_t)row * DM) + lane;
        f32x4 v[8]; float s = 0.f;
#pragma unroll
        for (int j = 0; j < 8; ++j) { v[j] = rp[64 * j]; s += (v[j].x + v[j].y) + (v[j].z + v[j].w); }
        const float mean = wave_sum(s) * (1.f / DM); float s2 = 0.f;
#pragma unroll
        for (int j = 0; j < 8; ++j) { v[j] = v[j] - mean; s2 += (v[j].x * v[j].x + v[j].y * v[j].y) + (v[j].z * v[j].z + v[j].w * v[j].w); }
        const float rstd = 1.f / sqrtf(wave_sum(s2) * (1.f / DM) + LN_EPS);
        u32x2* xp = (u32x2*)(XB + (size_t)row * DM) + lane;
#pragma unroll
        for (int j = 0; j < 8; ++j) {
            const f32x4 gg = ((const f32x4*)g)[64 * j + lane], bb = ((const f32x4*)b)[64 * j + lane];
            const f32x4 y = v[j] * rstd * gg + bb;
            rp[64 * j] = y;
            if (write_h) { u32x2 w; w.x = pk16(y.x, y.y); w.y = pk16(y.z, y.w); xp[64 * j] = w; }
        }
    }
}

__device__ __forceinline__ void ln_final(const h16* X, float* out, const float* g, const float* b, int gw, int NGW, int lane) {
    for (int row = gw; row < MTOK; row += NGW) {
        const h8* xp = (const h8*)(X + (size_t)row * DM) + lane;
        float v[4][8]; float s = 0.f;
#pragma unroll
        for (int j = 0; j < 4; ++j) { const h8 hv = __builtin_nontemporal_load(xp + 64 * j);
#pragma unroll
            for (int e = 0; e < 8; ++e) { v[j][e] = (float)hv[e]; s += v[j][e]; } }
        const float mean = wave_sum(s) * (1.f / DM); float s2 = 0.f;
#pragma unroll
        for (int j = 0; j < 4; ++j)
#pragma unroll
            for (int e = 0; e < 8; ++e) { v[j][e] -= mean; s2 += v[j][e] * v[j][e]; }
        const float rstd = 1.f / sqrtf(wave_sum(s2) * (1.f / DM) + LN_EPS);
#pragma unroll
        for (int j = 0; j < 4; ++j) { const int c0 = (64 * j + lane) * 8;
            const f32x4 g0 = *(const f32x4*)(g + c0), g1 = *(const f32x4*)(g + c0 + 4), b0 = *(const f32x4*)(b + c0), b1 = *(const f32x4*)(b + c0 + 4);
            const f32x4 y0 = (f32x4){v[j][0], v[j][1], v[j][2], v[j][3]} * rstd * g0 + b0, y1 = (f32x4){v[j][4], v[j][5], v[j][6], v[j][7]} * rstd * g1 + b1;
            __builtin_nontemporal_store(y0, (f32x4*)(out + (size_t)row * DM + c0)); __builtin_nontemporal_store(y1, (f32x4*)(out + (size_t)row * DM + c0 + 4)); }
    }
}

struct AttnArgs {
    const h16* q; long qstride;
    const h16* k; long kstride;
    const h16* k2; long k2stride;
    const h16* v; long vstride;
    int q0;
    int kt_lo, kt_hi;
    int rmax;
    float c1;
    float slope2;
    float sink2;
};
__device__ __forceinline__ int crow_off(int r) { return (r & 3) + 8 * (r >> 2); }

template <bool SB>
__device__ __forceinline__ int attn_tile(const h8 (&qf)[4], LAS unsigned char* kl, LAS unsigned char* vrd, int r32, int hi, int relb, int D, int rmax, float c1, float slope2,
                                         f32x16 (&o)[2], float& m, float& l, float& carry) {
    constexpr int VP = 144, KP = 144;
    f32x16 s;
#pragma unroll
    for (int r = 0; r < 16; ++r) s[r] = 0.f;
#pragma unroll
    for (int c = 0; c < 4; ++c) { const h8 kf = *(const LAS h8*)(kl + r32 * KP + (16 * c + 8 * hi) * 2); s = __builtin_amdgcn_mfma_f32_32x32x16_f16(kf, qf[c], s, 0, 0, 0); }
    float t[16]; int done = 0;
    if (!SB) {
        const float bb = -slope2 * (float)relb;
        float mt = -INFINITY;
        if (D == 0 || D + 31 > rmax) {
#pragma unroll
            for (int r = 0; r < 16; ++r) { const int rel = relb - crow_off(r); float x = fmaf(s[r], c1, fmaf(slope2, (float)crow_off(r), bb));
                x = (rel >= 0 && rel <= rmax) ? x : -INFINITY; t[r] = x; mt = fmaxf(mt, x); }
        } else {
#pragma unroll
            for (int r = 0; r < 16; ++r) { const float x = fmaf(s[r], c1, fmaf(slope2, (float)crow_off(r), bb)); t[r] = x; mt = fmaxf(mt, x); }
        }
        mt = fmaxf(mt, __shfl_xor(mt, 32));
        const float mn = fmaxf(m, mt);
        const float al = __builtin_amdgcn_exp2f(m - mn);
        float ls = 0.f;
#pragma unroll
        for (int r = 0; r < 16; ++r) { t[r] = __builtin_amdgcn_exp2f(t[r] - mn); ls += t[r]; }
        ls += __shfl_xor(ls, 32);
        l = l * al + ls; m = mn;
        if (__any(al != 1.f)) {
#pragma unroll
            for (int r = 0; r < 16; ++r) { o[0][r] *= al; o[1][r] *= al; } }
    } else {
        float L[16], lb[16];
#pragma unroll
        for (int r = 0; r < 16; ++r) { const float z = s[r] * c1;
            const float e = __expf(-fabsf(z)); const float sp = fmaxf(z, 0.f) + __logf(1.f + e);
            lb[r] = z - sp;
            L[r] = sp; }
        if (D == 0) {
#pragma unroll
            for (int r = 0; r < 16; ++r) { const bool ok = (relb - crow_off(r)) >= 1; L[r] = ok ? L[r] : 0.f; lb[r] = ok ? lb[r] : -INFINITY; } }
        float gs[4], pg[4], tail[4];
#pragma unroll
        for (int g = 0; g < 4; ++g) { gs[g] = (L[4 * g] + L[4 * g + 1]) + (L[4 * g + 2] + L[4 * g + 3]); pg[g] = __shfl_xor(gs[g], 32); }
        float run = 0.f;
#pragma unroll
        for (int g = 3; g >= 0; --g) { tail[g] = (hi == 0) ? run + pg[g] : run; run += gs[g] + pg[g]; }
#pragma unroll
        for (int g = 0; g < 4; ++g) { float af = carry + tail[g];
#pragma unroll
            for (int e = 3; e >= 0; --e) { const int r = 4 * g + e; t[r] = __expf(lb[r] - af); af += L[r]; } }
        carry += run;
        done = __all(carry > 40.f);
    }
    h8 pk0, pk1;
#pragma unroll
    for (int j = 0; j < 8; ++j) { pk0[j] = (_Float16)t[j]; pk1[j] = (_Float16)t[8 + j]; }
#pragma unroll
    for (int d0 = 0; d0 < 2; ++d0)
#pragma unroll
        for (int ks = 0; ks < 2; ++ks) {
            const v4i16_t lo = __builtin_amdgcn_ds_read_tr16_b64_v4i16((LAS v4i16_t*)(vrd + (16 * ks) * VP + d0 * 64));
            const v4i16_t hh = __builtin_amdgcn_ds_read_tr16_b64_v4i16((LAS v4i16_t*)(vrd + (16 * ks + 8) * VP + d0 * 64));
            const h8 vf = __builtin_bit_cast(h8, __builtin_shufflevector(lo, hh, 0, 1, 2, 3, 4, 5, 6, 7));
            o[d0] = __builtin_amdgcn_mfma_f32_32x32x16_f16(vf, ks ? pk1 : pk0, o[d0], 0, 0, 0);
        }
    return done;
}

template <int NC, bool SB>
__device__ __forceinline__ void attn_task(const AttnArgs& a, LAS unsigned char* vl, int lane, f32x16 (&o)[2], float& lse2) {
    static_assert(NC == 4, "the per-wave task handles 64-wide heads");
    constexpr int VP = 144, KP = 144;
    const int r32 = lane & 31, hi = lane >> 5;
    h8 qf[4];
    { const h16* qp = a.q + (long)(a.q0 + r32) * a.qstride + 8 * hi;
#pragma unroll
      for (int c = 0; c < 4; ++c) qf[c] = __builtin_nontemporal_load((const h8*)(qp + 16 * c)); }
#pragma unroll
    for (int r = 0; r < 16; ++r) { o[0][r] = 0.f; o[1][r] = 0.f; }
    float m = a.sink2, l = (a.sink2 > -1e30f) ? 1.f : 0.f, carry = 0.f;
    const int vrow = lane >> 3, vcc = lane & 7;
    const int q4 = (lane & 15) >> 2, p4 = lane & 3, dblk = (lane >> 4) & 1;
    LAS unsigned char* vrd = vl + (4 * hi + q4) * VP + dblk * 32 + p4 * 8;
    LAS unsigned char* kl = vl + 32 * VP;
    u32x4 kA[4], vA[4], kB[4], vB[4];
#define ATT_LOADKV(KS, VS, kt_) do { const int k0_ = (kt_) * 32; \
        _Pragma("unroll") for (int i = 0; i < 4; ++i) KS[i] = *(const u32x4*)(a.k + (long)(k0_ + i * 8 + vrow) * a.kstride + 8 * vcc); \
        _Pragma("unroll") for (int i = 0; i < 4; ++i) VS[i] = *(const u32x4*)(a.v + (long)(k0_ + i * 8 + vrow) * a.vstride + 8 * vcc); } while (0)
#define ATT_STEP(KS, VS, kt_) do { asm volatile("" ::: "memory"); \
        _Pragma("unroll") for (int i = 0; i < 4; ++i) { *(LAS u32x4*)(kl + (i * 8 + vrow) * KP + vcc * 16) = KS[i]; *(LAS u32x4*)(vl + (i * 8 + vrow) * VP + vcc * 16) = VS[i]; } \
        asm volatile("" ::: "memory"); \
        { const int ktn_ = ((kt_) - 2 >= a.kt_lo) ? (kt_) - 2 : a.kt_lo; ATT_LOADKV(KS, VS, ktn_); }     \
        done = attn_tile<SB>(qf, kl, vrd, r32, hi, a.q0 + r32 - (kt_) * 32 - 4 * hi, a.q0 - (kt_) * 32, a.rmax, a.c1, a.slope2, o, m, l, carry); \
        asm volatile("" ::: "memory"); } while (0)
    int done = 0;
    ATT_LOADKV(kA, vA, a.kt_hi);
    { const int kt1 = (a.kt_hi - 1 >= a.kt_lo) ? a.kt_hi - 1 : a.kt_lo; ATT_LOADKV(kB, vB, kt1); }
    for (int kt = a.kt_hi; kt >= a.kt_lo; kt -= 2) {
        ATT_STEP(kA, vA, kt);
        if (SB && done) break;
        if (kt - 1 < a.kt_lo) break;
        ATT_STEP(kB, vB, kt - 1);
        if (SB && done) break;
    }
#undef ATT_LOADKV
#undef ATT_STEP
    if (!SB) {
        const float inv = 1.f / l;
#pragma unroll
        for (int r = 0; r < 16; ++r) { o[0][r] *= inv; o[1][r] *= inv; }
        lse2 = m + __log2f(l);
    } else lse2 = 0.f;
}
__device__ __forceinline__ void store_o16(const f32x16 (&o)[2], h16* orow, int hi) {
#pragma unroll
    for (int d0 = 0; d0 < 2; ++d0)
#pragma unroll
        for (int g = 0; g < 4; ++g) { u32x2 w; w.x = pk16(o[d0][4 * g], o[d0][4 * g + 1]); w.y = pk16(o[d0][4 * g + 2], o[d0][4 * g + 3]);
            *(u32x2*)(orow + 32 * d0 + 8 * g + 4 * hi) = w; }
}
__device__ __forceinline__ void store_o32(const f32x16 (&o)[2], float* orow, int hi) {
#pragma unroll
    for (int d0 = 0; d0 < 2; ++d0)
#pragma unroll
        for (int g = 0; g < 4; ++g) { f32x4 w = {o[d0][4 * g], o[d0][4 * g + 1], o[d0][4 * g + 2], o[d0][4 * g + 3]};
            *(f32x4*)(orow + 32 * d0 + 8 * g + 4 * hi) = w; }
}

struct ABUnit { int isA, b, h, g, d, res0, u, qb; };
__device__ __forceinline__ ABUnit ab_decode(int U) {
    ABUnit x; x.isA = U < 1024;
    if (x.isA) { x.b = U >> 7; x.h = (U >> 6) & 1; x.qb = U & 63; x.g = 0; x.d = 1; x.res0 = 0; x.u = 0; }
    else { const int V = (U - 1024) & 511; x.g = (U - 1024) >> 9; x.b = V >> 6; x.h = (V >> 3) & 7; x.qb = 0;
        if (x.g == 0) { x.d = 1; x.res0 = 0; x.u = V & 7; } else if (x.g == 1) { x.d = 4; x.res0 = (V >> 1) & 3; x.u = V & 1; } else { x.d = 16; x.res0 = 2 * (V & 7); x.u = 0; } }
    return x;
}
#define AB_BAR() asm volatile("s_waitcnt lgkmcnt(0)\n\ts_barrier" ::: "memory")
__device__ __forceinline__ void ab_phase(const h16* H, const float* sinks, h16* Y, h16* PO16, float* LSE, LAS unsigned char* lds, int G) {
    constexpr int SLOT = 9216, VP = 144, NU = 2560;
    int tid = threadIdx.x; asm volatile("" : "+v"(tid));
    const int lane = tid & 63, w = __builtin_amdgcn_readfirstlane(tid >> 6), r32 = lane & 31, hi = lane >> 5;
    const int isV = tid >> 8, lrow = (tid & 255) >> 3, lcc = tid & 7;
    const int q4 = (lane & 15) >> 2, p4 = lane & 3, dblk = (lane >> 4) & 1;
    const int vrd_off = (4 * hi + q4) * VP + dblk * 32 + p4 * 8;
    LAS unsigned char* wdst = lds + (isV ? 0 : 32 * VP) + lrow * VP + lcc * 16;
    u32x4 tr[12]; h8 qn[4];
#define AB_ISSUE(U_) do { const ABUnit x_ = ab_decode(U_); \
        const long stride_ = (long)x_.d * EVEN_IN; \
        const h16* kb0_ = x_.isA ? H + (size_t)(x_.b * SEQ) * EVEN_IN + 1024 + x_.h * 64 : H + (size_t)(x_.b * SEQ + x_.res0) * EVEN_IN + 1280 + x_.g * 1536 + x_.h * 64 + 512; \
        const int voff_ = x_.isA ? 128 : 512; \
        const h16* lp_ = kb0_ + (isV ? voff_ : 0) + (long)lrow * stride_ + 8 * lcc; \
        const int kt0_ = x_.isA ? x_.qb - 4 : (x_.d == 16 ? 0 : 8 * x_.u - 4), nt_ = x_.isA ? 5 : (x_.d == 16 ? 8 : 12); \
        _Pragma("unroll") for (int i = 0; i < 12; ++i) { const int kt_ = (x_.d == 16) ? (i & 3) : kt0_ + i; const int sg_ = (x_.d == 16) ? (i >> 2) : 0; \
            if (i < nt_ && kt_ >= 0) tr[i] = *(const u32x4*)(lp_ + (long)sg_ * EVEN_IN + (long)(32 * kt_) * stride_); } \
        { const int qbw_ = x_.isA ? x_.qb : (x_.d == 16 ? (w & 3) : 8 * x_.u + w); const int sgw_ = (x_.d == 16) ? (w >> 2) : 0; \
          const h16* qp_ = (x_.isA ? H + (size_t)(x_.b * SEQ) * EVEN_IN + (x_.h * 8 + w) * 64 : kb0_ - 512 + (long)sgw_ * EVEN_IN) + (long)(32 * qbw_ + r32) * stride_ + 8 * hi; \
          _Pragma("unroll") for (int c = 0; c < 4; ++c) qn[c] = __builtin_nontemporal_load((const h8*)(qp_ + 16 * c)); } } while (0)
    int U = ((gridDim.x % 8 == 0) ? (int)((blockIdx.x % 8) * (gridDim.x / 8) + blockIdx.x / 8) : (int)blockIdx.x);
    if (U < NU) AB_ISSUE(U);
    for (; U < NU; U += G) {
        AB_BAR();
#pragma unroll
        for (int i = 0; i < 12; ++i) *(LAS u32x4*)(wdst + i * SLOT) = tr[i];
        h8 qf[4];
#pragma unroll
        for (int c = 0; c < 4; ++c) qf[c] = qn[c];
        AB_BAR();
        if (U + G < NU) AB_ISSUE(U + G);
        const ABUnit x = ab_decode(U);
        const int qbw = x.isA ? x.qb : (x.d == 16 ? (w & 3) : 8 * x.u + w);
        const int slot0 = x.isA ? 4 : (x.d == 16 ? (w >> 2) * 4 + (w & 3) : w + 4);
        const int njt = qbw + 1 < 5 ? qbw + 1 : 5;
        const int hq = x.isA ? x.h * 8 + w : x.h;
        const float slope2 = x.isA ? __builtin_amdgcn_exp2f(-0.5f * (float)(hq + 1)) * LOG2E : __builtin_amdgcn_exp2f(-(float)(hq + 1)) * (float)x.d * LOG2E;
        const float sink2 = x.isA ? sinks[hq] * LOG2E : -INFINITY;
        const int rmax = x.isA ? 127 : 128;
        f32x16 o[2];
#pragma unroll
        for (int r = 0; r < 16; ++r) { o[0][r] = 0.f; o[1][r] = 0.f; }
        float m = sink2, l = x.isA ? 1.f : 0.f, carry = 0.f;
        for (int j = 0; j < njt; ++j) {
            LAS unsigned char* vl = lds + (slot0 - j) * SLOT;
            (void)attn_tile<false>(qf, vl + 32 * VP, vl + vrd_off, r32, hi, 32 * j + r32 - 4 * hi, 32 * j, rmax, 0.125f * LOG2E, slope2, o, m, l, carry);
        }
        const float inv = 1.f / l;
#pragma unroll
        for (int r = 0; r < 16; ++r) { o[0][r] *= inv; o[1][r] *= inv; }
        if (x.isA) store_o16(o, Y + (size_t)(x.b * SEQ + 32 * qbw + r32) * EVEN_OUT + hq * 64, hi);
        else { const int resw = x.res0 + ((x.d == 16) ? (w >> 2) : 0); const size_t tok = (size_t)(x.b * SEQ + resw + x.d * (32 * qbw + r32));
            store_o16(o, PO16 + ((size_t)x.g * MTOK + tok) * 512 + hq * 64, hi);
            if (lane < 32) LSE[((size_t)x.g * MTOK + tok) * 8 + hq] = (m + __log2f(l)) * LN2; }
    }
#undef AB_ISSUE
    AB_BAR();
}

__device__ __forceinline__ void mla_tile(LAS unsigned char* bb, int T, int dtile, int qrow0, int r32, int hi, int vrd_off, float c1, const h8 (&qf)[6], f32x16 (&o)[2], float& m, float& l) {
    constexpr int KP = 208, VP = 144, KBYTES = 64 * KP;
                if (2 * T <= dtile) {
                    f32x16 s0, s1;
#pragma unroll
                    for (int r = 0; r < 16; ++r) { s0[r] = 0.f; s1[r] = 0.f; }
#pragma unroll
                    for (int c = 0; c < 6; ++c) { const h8 kf0 = *(const LAS h8*)(bb + r32 * KP + (16 * c + 8 * hi) * 2), kf1 = *(const LAS h8*)(bb + (32 + r32) * KP + (16 * c + 8 * hi) * 2);
                        s0 = __builtin_amdgcn_mfma_f32_32x32x16_f16(kf0, qf[c], s0, 0, 0, 0); s1 = __builtin_amdgcn_mfma_f32_32x32x16_f16(kf1, qf[c], s1, 0, 0, 0); }
                    float mt = -INFINITY;
                    if (2 * T + 1 >= dtile) {
                        const int relb = qrow0 - 64 * T + r32 - 4 * hi;
#pragma unroll
                        for (int r = 0; r < 16; ++r) { const int rel = relb - crow_off(r); s0[r] = (rel >= 0) ? s0[r] : -INFINITY; s1[r] = (rel >= 32) ? s1[r] : -INFINITY; }
                    }
#pragma unroll
                    for (int r = 0; r < 16; ++r) mt = fmaxf(mt, fmaxf(s0[r], s1[r]));
                    mt = fmaxf(mt, __shfl_xor(mt, 32));
                    const float mn = fmaxf(m, mt * c1);
                    const float al = __builtin_amdgcn_exp2f(m - mn);
                    float ls = 0.f;
#pragma unroll
                    for (int r = 0; r < 16; ++r) { s0[r] = __builtin_amdgcn_exp2f(fmaf(s0[r], c1, -mn)); s1[r] = __builtin_amdgcn_exp2f(fmaf(s1[r], c1, -mn)); ls += s0[r] + s1[r]; }
                    ls += __shfl_xor(ls, 32);
                    l = l * al + ls; m = mn;
                    if (__any(al != 1.f)) {
#pragma unroll
                        for (int r = 0; r < 16; ++r) { o[0][r] *= al; o[1][r] *= al; } }
                    h8 pk[4];
#pragma unroll
                    for (int e = 0; e < 8; ++e) { pk[0][e] = (_Float16)s0[e]; pk[1][e] = (_Float16)s0[8 + e]; pk[2][e] = (_Float16)s1[e]; pk[3][e] = (_Float16)s1[8 + e]; }
#pragma unroll
                    for (int d0 = 0; d0 < 2; ++d0)
#pragma unroll
                        for (int ks = 0; ks < 4; ++ks) {
                            LAS unsigned char* vp = bb + KBYTES + vrd_off + (16 * ks) * VP + d0 * 64;
                            const v4i16_t lo = __builtin_amdgcn_ds_read_tr16_b64_v4i16((LAS v4i16_t*)(vp));
                            const v4i16_t hh = __builtin_amdgcn_ds_read_tr16_b64_v4i16((LAS v4i16_t*)(vp + 8 * VP));
                            const h8 vf = __builtin_bit_cast(h8, __builtin_shufflevector(lo, hh, 0, 1, 2, 3, 4, 5, 6, 7));
                            o[d0] = __builtin_amdgcn_mfma_f32_32x32x16_f16(vf, pk[ks], o[d0], 0, 0, 0);
                        }
                }
}

__device__ __forceinline__ void mla_phase(const h16* Q2, const h16* KV, const h16* KR, h16* Y2, LAS unsigned char* lds, int G) {
    constexpr int KP = 208, VP = 144, KBYTES = 64 * KP, BUFB = KBYTES + 64 * VP;
    int tid = threadIdx.x; asm volatile("" : "+v"(tid));
    const int lane = tid & 63, w = __builtin_amdgcn_readfirstlane(tid >> 6), r32 = lane & 31, hi = lane >> 5;
    const float c1 = 0.10206207261596575f * LOG2E;
    const int krow = tid >> 3, kcc = tid & 7, rrow = tid >> 2, rcc = tid & 3;
    const int q4 = (lane & 15) >> 2, p4 = lane & 3, dblk = (lane >> 4) & 1;
    const int vrd_off = (4 * hi + q4) * VP + dblk * 32 + p4 * 8;
    for (int slot = ((gridDim.x % 8 == 0) ? (int)((blockIdx.x % 8) * (gridDim.x / 8) + blockIdx.x / 8) : (int)blockIdx.x); slot < 256; slot += G) {
        for (int ui = 0; ui < 4; ++ui) {
            const int bh = 2 * (slot >> 2) + (ui >> 1), u = (ui & 1) ? 7 - (slot & 3) : (slot & 3);
            const int b = bh >> 4, h = bh & 15;
            const h16* kbase = KV + (size_t)(b * SEQ) * UKV_N + h * 128;
            const h16* rbase = KR + (size_t)(b * SEQ) * 32;
            const int qrow0 = 256 * u + 32 * w, dtile = 8 * u + w;
            h8 qf[6];
            { const h16* qp = Q2 + (size_t)(b * SEQ + qrow0 + r32) * UQ_N + h * 96 + 8 * hi;
#pragma unroll
              for (int c = 0; c < 6; ++c) qf[c] = __builtin_nontemporal_load((const h8*)(qp + 16 * c)); }
            f32x16 o[2];
#pragma unroll
            for (int r = 0; r < 16; ++r) { o[0][r] = 0.f; o[1][r] = 0.f; }
            float m = -INFINITY, l = 0.f;
            u32x4 skA, svA, srA = {0u, 0u, 0u, 0u}, skB, svB, srB = {0u, 0u, 0u, 0u};
#define MLA_LOAD(SK, SV, SR, T_) do { const int tt_ = (T_) > 0 ? (T_) : 0; const size_t rr_ = (size_t)(64 * tt_ + krow); SK = *(const u32x4*)(kbase + rr_ * UKV_N + 8 * kcc); SV = *(const u32x4*)(kbase + rr_ * UKV_N + 64 + 8 * kcc); \
                if (tid < 256) SR = *(const u32x4*)(rbase + (size_t)(64 * tt_ + rrow) * 32 + 8 * rcc); } while (0)
#define MLA_STORE(SK, SV, SR, buf_) do { LAS unsigned char* bb_ = lds + (buf_) * BUFB; *(LAS u32x4*)(bb_ + krow * KP + kcc * 16) = SK; *(LAS u32x4*)(bb_ + KBYTES + krow * VP + kcc * 16) = SV; \
                if (tid < 256) *(LAS u32x4*)(bb_ + rrow * KP + 128 + rcc * 16) = SR; } while (0)
#define MLA_BAR() asm volatile("s_waitcnt lgkmcnt(0)\n\ts_barrier" ::: "memory")
            int T = 4 * u + 3;
            MLA_LOAD(skA, svA, srA, T); MLA_STORE(skA, svA, srA, 0);
            MLA_LOAD(skA, svA, srA, T - 1); MLA_LOAD(skB, svB, srB, T - 2);
            MLA_BAR();
            for (; T >= 0; T -= 2) {
                if (2 * T <= dtile) mla_tile(lds, T, dtile, qrow0, r32, hi, vrd_off, c1, qf, o, m, l);
                MLA_STORE(skA, svA, srA, 1);
                MLA_LOAD(skA, svA, srA, T - 3);
                MLA_BAR();
                if (2 * (T - 1) <= dtile) mla_tile(lds + BUFB, T - 1, dtile, qrow0, r32, hi, vrd_off, c1, qf, o, m, l);
                MLA_STORE(skB, svB, srB, 0);
                MLA_LOAD(skB, svB, srB, T - 4);
                MLA_BAR();
            }
#undef MLA_BAR
#undef MLA_LOAD
#undef MLA_STORE
            const float inv = 1.f / l;
#pragma unroll
            for (int r = 0; r < 16; ++r) { o[0][r] *= inv; o[1][r] *= inv; }
            store_o16(o, Y2 + (size_t)(b * SEQ + qrow0 + r32) * DM + 1024 + h * 64, hi);
        }
    }
}

#define XB_TMO      128
#define XB_XCNT(j)  (256  + 64 * (j))
#define XB_XSUB(j)  (1280 + 64 * (j))
#define XB_XGEN(j)  (2304 + 64 * (j))
#define XB_TOP      3328
#define XB_TOPGEN   3392
#define XCD_BAR_WORDS 3456
#define XB_SPIN_CAP (1u << 18)

__device__ __forceinline__ unsigned xb_ld(unsigned* p)              { return __hip_atomic_load(p, __ATOMIC_RELAXED, __HIP_MEMORY_SCOPE_AGENT); }
__device__ __forceinline__ unsigned xb_add(unsigned* p, unsigned v) { return __hip_atomic_fetch_add(p, v, __ATOMIC_RELAXED, __HIP_MEMORY_SCOPE_AGENT); }
__device__ __forceinline__ unsigned xb_xcc_id() { return (unsigned)__builtin_amdgcn_s_getreg((3 << 11) | 20) & 0xFu; }
#define XB_SPIN(cond, bar) do { unsigned _sp = 0; while (cond) { __builtin_amdgcn_s_sleep(1); \
    if ((++_sp & 255u) == 0u) { if (xb_ld(&(bar)[XB_TMO])) break; if (_sp > XB_SPIN_CAP) { atomicAdd(&(bar)[XB_TMO], 1u); break; } } } } while (0)

struct XcdBarrier {
    unsigned* bar; unsigned x;
    volatile LAS unsigned* st;
};

__device__ __forceinline__ XcdBarrier xcd_barrier_post(unsigned* bar, volatile LAS unsigned* st) {
    XcdBarrier b; b.bar = bar; b.x = xb_xcc_id(); b.st = st;
    if (threadIdx.x == 0) (void)xb_add(&bar[XB_XCNT(b.x)], 1u);
    return b;
}
__device__ __forceinline__ void xcd_barrier_complete(unsigned* bar, unsigned x, unsigned& nloc, unsigned& nx) {
    const unsigned G = gridDim.x * gridDim.y * gridDim.z;
    unsigned sum, cnt, mine, sp = 0u;
    for (;;) {
        sum = 0u; cnt = 0u; mine = 0u;
#pragma unroll
        for (unsigned j = 0; j < 16; ++j) { const unsigned c = xb_ld(&bar[XB_XCNT(j)]); sum += c; cnt += (c > 0u) ? 1u : 0u; mine = (j == x) ? c : mine; }
        if (sum == G) break;
        __builtin_amdgcn_s_sleep(1);
        if ((++sp & 255u) == 0u) { if (xb_ld(&bar[XB_TMO])) break; if (sp > XB_SPIN_CAP) { atomicAdd(&bar[XB_TMO], 1u); break; } }
    }
    nloc = mine > 0u ? mine : 1u; nx = cnt > 0u ? cnt : 1u;
}

__device__ __forceinline__ void xcd_barrier(const XcdBarrier& b) {
    asm volatile("s_waitcnt vmcnt(0)" ::: "memory");
    __syncthreads();
    if (threadIdx.x == 0) {
        unsigned* bar = b.bar;
        __builtin_amdgcn_s_waitcnt(0);
        unsigned nloc = b.st[0], nx = b.st[1];
        if (nloc == 0u) { xcd_barrier_complete(bar, b.x, nloc, nx); b.st[0] = nloc; b.st[1] = nx; }
        const unsigned old = xb_add(&bar[XB_XSUB(b.x)], 1u);
        const unsigned gen = old / nloc;
        if (old + 1u == (gen + 1u) * nloc) {
            __builtin_amdgcn_fence(__ATOMIC_RELEASE, "agent");
            asm volatile("s_waitcnt vmcnt(0)" ::: "memory");
            const unsigned og = xb_add(&bar[XB_TOP], 1u);
            const unsigned tg = og / nx;
            if (og + 1u == (tg + 1u) * nx) xb_add(&bar[XB_TOPGEN], 1u);
            else XB_SPIN(xb_ld(&bar[XB_TOPGEN]) == tg, bar);
            __builtin_amdgcn_fence(__ATOMIC_ACQUIRE, "agent");
            xb_add(&bar[XB_XGEN(b.x)], 1u);
            asm volatile("s_waitcnt vmcnt(0)" ::: "memory");
        } else {
            XB_SPIN(xb_ld(&bar[XB_XGEN(b.x)]) == gen, bar);
            __builtin_amdgcn_fence(__ATOMIC_ACQUIRE, "agent");
            asm volatile("s_waitcnt vmcnt(0)" ::: "memory");
        }
    }
    __syncthreads();
}

__global__ void __launch_bounds__(NWAVES * 64, 2) mega_fwd(Params P) {
    extern __shared__ __attribute__((aligned(16))) unsigned char lds_raw[];
    cg::grid_group grid = cg::this_grid();
    LAS unsigned char* lds = (LAS unsigned char*)lds_raw;
    const int G = gridDim.x, NGW = G * NWAVES; const long NGT = (long)G * (NWAVES * 64);
    volatile LAS unsigned* MISC = (volatile LAS unsigned*)(lds + 131072 + 512);
    if (threadIdx.x < 8) MISC[threadIdx.x] = 0u;
    __syncthreads();
    const XcdBarrier bar = xcd_barrier_post((unsigned*)(P.ws + WS_BAR), MISC);
    if (P.ws == nullptr) grid.sync();
#define TID_SETUP int tid = threadIdx.x; asm volatile("" : "+v"(tid)); const int lane = tid & 63, wave = __builtin_amdgcn_readfirstlane(tid >> 6); \
    const int vcu_ = (gridDim.x % 8 == 0) ? (int)((blockIdx.x % 8) * (gridDim.x / 8) + blockIdx.x / 8) : (int)blockIdx.x;     \
    const int gw = vcu_ * NWAVES + wave; const long gt = (long)blockIdx.x * (NWAVES * 64) + tid; LAS unsigned char* wlds = lds + wave * 16384; (void)gt; (void)gw; (void)lane; (void)wlds;
#define WS_SETUP unsigned char* ws = P.ws; asm volatile("" : "+s"(ws)); float* R = P.out; asm volatile("" : "+s"(R)); (void)R;
#define x_in (P.in[0])
#define XB ((h16*)(ws + WS_XB))
#define HID ((h16*)(ws + WS_HID))
#define H ((h16*)(ws + WS_H))
#define Y ((h16*)(ws + WS_Y))
#define H2 ((h16*)(ws + WS_H2))
#define CQN ((h16*)(ws + WS_CQN))
#define CKVN ((h16*)(ws + WS_CKVN))
#define KR ((h16*)(ws + WS_KR))
#define Q2 ((h16*)(ws + WS_Q2))
#define KV ((h16*)(ws + WS_KV))
#define Y2 ((h16*)(ws + WS_Y2))
#define ROPE ((float*)(ws + WS_ROPE))
#define STATS ((float*)(ws + WS_STATS))
#define C1 ((float*)(ws + WS_C12))
#define C2 (C1 + 20480)
#define PO ((h16*)R)
#define LSE (R + OUT_LSE)
#define XR ((h16*)R)

    { WS_SETUP TID_SETUP
            LAS float* scr = (LAS float*)wlds;
            for (long i = gt; i < (long)(3 * MTOK * 2 + 2 * 20480) / 4; i += NGT) { f32x4* z = (i < 3 * MTOK * 2 / 4) ? (f32x4*)STATS + i : (f32x4*)C1 + (i - 3 * MTOK * 2 / 4); *z = (f32x4){0.f, 0.f, 0.f, 0.f}; }
            for (int wi = 0; wi < 10; ++wi) {
                if (wi == 2 || wi == 4 || wi == 8) continue;
                const float* W; int K, N; size_t dst;
                switch (wi) {
                    case 0: W = P.in[1]; K = DM; N = EVEN_IN; dst = WS_W_EIN; break;
                    case 1: W = P.in[3]; K = EVEN_OUT; N = DM; dst = WS_W_EOUT; break;
                    case 2: W = P.in[12]; K = DM; N = DFF; dst = WS_W_W1A; break;
                    case 3: W = P.in[13]; K = DFF; N = DM; dst = WS_W_W2A; break;
                    case 4: W = P.in[4]; K = DM; N = ODD_IN; dst = WS_W_OIN; break;
                    case 5: W = P.in[7]; K = 512; N = UQ_N; dst = WS_W_UQ; break;
                    case 6: W = P.in[8]; K = 256; N = UKV_N; dst = WS_W_UKV; break;
                    case 7: W = P.in[9]; K = DM; N = DM; dst = WS_W_OOUT; break;
                    case 8: W = P.in[12] + (size_t)DM * DFF; K = DM; N = DFF; dst = WS_W_W1B; break;
                    default: W = P.in[13] + (size_t)DM * DFF; K = DFF; N = DM; dst = WS_W_W2B; break;
                }
                const int nitems = (K / 64) * (N / 32);
                for (int it = gw; it < nitems; it += NGW) transpose_item(W, K, N, (h16*)(ws + dst), it, scr, lane);
            }
            {
                u32x4* z = (u32x4*)(ws + WS_W_OIN + (size_t)ODD_IN * DM * 2); const long n16 = (long)(ODD_INP - ODD_IN) * DM * 2 / 16;
                for (long i = gt; i < n16; i += NGT) z[i] = (u32x4){0u, 0u, 0u, 0u}; }
            {
                const long n8 = (long)MTOK * DM / 8;
                for (long i = gt; i < n8; i += 4 * NGT) {
                    f32x4 a[4], b[4];
#pragma unroll
                    for (int j = 0; j < 4; ++j) { const long ii = i + j * NGT; if (ii < n8) { a[j] = ((const f32x4*)x_in)[2 * ii]; b[j] = ((const f32x4*)x_in)[2 * ii + 1]; } }
#pragma unroll
                    for (int j = 0; j < 4; ++j) { const long ii = i + j * NGT; if (ii < n8) { u32x4 w; w.x = pk16(a[j].x, a[j].y); w.y = pk16(a[j].z, a[j].w); w.z = pk16(b[j].x, b[j].y); w.w = pk16(b[j].z, b[j].w); ((u32x4*)XB)[ii] = w; } } } }
            for (long i = gt; i < SEQ * 16; i += NGT) { const int pos = (int)(i >> 4), fi = (int)(i & 15);
                double invd = 1.0; for (int e = 0; e < fi; ++e) invd *= 0.56234132519034907;
                const float inv = (float)invd;
                const float ang = (float)pos * inv; double s, c; sincos_d((double)ang, s, c);
                ROPE[pos * 32 + fi] = (float)c; ROPE[pos * 32 + 16 + fi] = (float)s; }
    }
    xcd_barrier(bar);
    { WS_SETUP pg8::Gemm g{XB, (const h16*)(ws + WS_W_EIN), MTOK, EVEN_IN, DM}; pg8::EpiAny<0, 0> E{}; E.O = H; E.ldc = EVEN_IN;
      pg8::StaticOrder S; S.init(MTOK, EVEN_IN, G, (int)blockIdx.x, WGM_IN);
      pg8::gemm_phase<pg8::EpiAny<0, 0>, pg8::StaticOrder, true, true>(lds, g, S, E); }
    xcd_barrier(bar);
    { WS_SETUP TID_SETUP
            ab_phase(H, P.in[2], Y, PO, LSE, lds, G);
    }
    xcd_barrier(bar);
    { WS_SETUP TID_SETUP
            for (long i = gt; i < (long)MTOK * 128; i += NGT) { const size_t tok = (size_t)(i >> 7); const int h = (int)((i >> 4) & 7), dg = (int)(i & 15);
                const float l0 = LSE[tok * 8 + h], l1 = LSE[((size_t)MTOK + tok) * 8 + h], l2 = LSE[((size_t)2 * MTOK + tok) * 8 + h];
                const float mx = fmaxf(l0, fmaxf(l1, l2)); const float w0 = __expf(l0 - mx), w1 = __expf(l1 - mx), w2 = __expf(l2 - mx); const float iw = 1.f / (w0 + w1 + w2);
                const size_t po = tok * 512 + h * 64 + dg * 4;
                const h4 q0 = __builtin_nontemporal_load((const h4*)(PO + po)), q1 = __builtin_nontemporal_load((const h4*)(PO + (size_t)MTOK * 512 + po)), q2 = __builtin_nontemporal_load((const h4*)(PO + (size_t)2 * MTOK * 512 + po));
                const f32x4 a0 = {(float)q0[0], (float)q0[1], (float)q0[2], (float)q0[3]}, a1 = {(float)q1[0], (float)q1[1], (float)q1[2], (float)q1[3]}, a2 = {(float)q2[0], (float)q2[1], (float)q2[2], (float)q2[3]};
                const f32x4 r = (a0 * w0 + a1 * w1 + a2 * w2) * iw;
                u32x2 w; w.x = pk16(r.x, r.y); w.y = pk16(r.z, r.w); *(u32x2*)(Y + tok * EVEN_OUT + 1024 + h * 64 + dg * 4) = w; }
            { LAS float* scr = (LAS float*)wlds;
              for (int wi = 0; wi < 3; ++wi) {
                const float* W = (wi == 0) ? P.in[12] : (wi == 1) ? P.in[4] : P.in[12] + (size_t)DM * DFF;
                const int N = (wi == 1) ? ODD_IN : DFF; const size_t dst = (wi == 0) ? WS_W_W1A : (wi == 1) ? WS_W_OIN : WS_W_W1B;
                const float* gg = (wi == 0) ? P.in[10] : (wi == 1) ? P.in[14] : P.in[10] + DM; const float* bb = (wi == 0) ? P.in[11] : (wi == 1) ? P.in[15] : P.in[11] + DM;
                const int coff = (wi == 0) ? 0 : (wi == 1) ? 8192 : 12288;
                const int nitems = (DM / 64) * (N / 32);
                for (int it = gw; it < nitems; it += NGW) transpose_item_fold(W, DM, N, (h16*)(ws + dst), it, scr, lane, gg, bb, C1 + coff, C2 + coff);
              } }
    }
    xcd_barrier(bar);
    { WS_SETUP pg8::Gemm g{Y, (const h16*)(ws + WS_W_EOUT), MTOK, DM, EVEN_OUT}; pg8::EpiAny<2, 0> E{}; E.xbase = XB  ; E.ldc = DM; E.alpha = ALPHA; E.xb = XB; E.st_out = STATS;
      pg8::StaticOrder S; S.init(MTOK, DM, G, (int)blockIdx.x, WGM_N2048);
      pg8::gemm_phase<pg8::EpiAny<2, 0>, pg8::StaticOrder, true, true>(lds, g, S, E); }
    xcd_barrier(bar);
    { WS_SETUP pg8::Gemm g{XB, (const h16*)(ws + WS_W_W1A), MTOK, DFF, DM}; pg8::EpiAny<1, 1> E{}; E.O = HID; E.ldc = DFF; E.st_in = STATS; E.c1 = C1; E.c2 = C2;
      pg8::StaticOrder S; S.init(MTOK, DFF, G, (int)blockIdx.x, WGM_UP);
      pg8::gemm_phase<pg8::EpiAny<1, 1>, pg8::StaticOrder, true, true>(lds, g, S, E); }
    xcd_barrier(bar);
    { WS_SETUP pg8::Gemm g{HID, (const h16*)(ws + WS_W_W2A), MTOK, DM, DFF}; pg8::EpiAny<2, 1> E{}; E.xbase = XB; E.ldc = DM; E.alpha = ALPHA; E.st_in = STATS; E.g = P.in[10]; E.b = P.in[11]; E.xb = XR; E.st_out = STATS + 2 * MTOK;
      pg8::StaticOrder S; S.init(MTOK, DM, G, (int)blockIdx.x, WGM_N2048, 4);
      pg8::gemm_phase<pg8::EpiAny<2, 1>, pg8::StaticOrder, true, true>(lds, g, S, E); }
    xcd_barrier(bar);
    { WS_SETUP pg8::Gemm g{XR, (const h16*)(ws + WS_W_OIN), MTOK, ODD_INP, DM}; pg8::EpiAny<0, 1> E{}; E.O = H2; E.ldc = ODD_INP; E.st_in = STATS + 2 * MTOK; E.c1 = C1 + 8192; E.c2 = C2 + 8192;
      pg8::StaticOrder S; S.init(MTOK, ODD_INP, G, (int)blockIdx.x, WGM_IN);
      pg8::gemm_phase<pg8::EpiAny<0, 1>, pg8::StaticOrder, true, true>(lds, g, S, E); }
    xcd_barrier(bar);
    { WS_SETUP TID_SETUP
            const float* gq = P.in[5]; const float* gkv = P.in[6];
            for (int row = gw; row < MTOK; row += NGW) {
                const h16* hp = H2 + (size_t)row * ODD_INP;
                const h8 cq = *(const h8*)(hp + 3072 + 8 * lane); const h4 ck = *(const h4*)(hp + 3584 + 4 * lane);
                float xq[8], xk[4], sq = 0.f, sk = 0.f;
#pragma unroll
                for (int e = 0; e < 8; ++e) { xq[e] = (float)cq[e]; sq += xq[e] * xq[e]; }
#pragma unroll
                for (int e = 0; e < 4; ++e) { xk[e] = (float)ck[e]; sk += xk[e] * xk[e]; }
                const float rq = 1.f / sqrtf(wave_sum(sq) * (1.f / 512.f) + RMS_EPS), rk = 1.f / sqrtf(wave_sum(sk) * (1.f / 256.f) + RMS_EPS);
                const f32x4 g0 = *(const f32x4*)(gq + 8 * lane), g1 = *(const f32x4*)(gq + 8 * lane + 4), g2 = *(const f32x4*)(gkv + 4 * lane);
                u32x4 wq; wq.x = pk16(xq[0] * rq * g0.x, xq[1] * rq * g0.y); wq.y = pk16(xq[2] * rq * g0.z, xq[3] * rq * g0.w);
                wq.z = pk16(xq[4] * rq * g1.x, xq[5] * rq * g1.y); wq.w = pk16(xq[6] * rq * g1.z, xq[7] * rq * g1.w);
                *(u32x4*)(CQN + (size_t)row * 512 + 8 * lane) = wq;
                u32x2 wk; wk.x = pk16(xk[0] * rk * g2.x, xk[1] * rk * g2.y); wk.y = pk16(xk[2] * rk * g2.z, xk[3] * rk * g2.w);
                *(u32x2*)(CKVN + (size_t)row * 256 + 4 * lane) = wk;
                if (lane < 16) { const int pos = row & (SEQ - 1);
                    const float x1 = (float)*(const _Float16*)(hp + 3840 + lane), x2 = (float)*(const _Float16*)(hp + 3856 + lane);
                    const float c = ROPE[pos * 32 + lane], s = ROPE[pos * 32 + 16 + lane];
                    *(_Float16*)(KR + (size_t)row * 32 + lane) = (_Float16)(x1 * c - x2 * s);
                    *(_Float16*)(KR + (size_t)row * 32 + 16 + lane) = (_Float16)(x1 * s + x2 * c); }
            }
    }
    xcd_barrier(bar);
    { WS_SETUP pg8::Gemm g{CQN, (const h16*)(ws + WS_W_UQ), MTOK, UQ_N, 512}; pg8::EpiAny<3, 0> E{}; E.O = Q2; E.ldc = UQ_N; E.rope = ROPE;
      pg8::StaticOrder S; S.init(MTOK, UQ_N, G, (int)blockIdx.x, WGM_SMALL);
      pg8::gemm_phase<pg8::EpiAny<3, 0>, pg8::StaticOrder, true, true>(lds, g, S, E); }
    { WS_SETUP pg8::Gemm g{CKVN, (const h16*)(ws + WS_W_UKV), MTOK, UKV_N, 256}; pg8::EpiAny<0, 0> E{}; E.O = KV; E.ldc = UKV_N;
      pg8::StaticOrder S; S.init(MTOK, UKV_N, G, (int)blockIdx.x, WGM_SMALL);
      pg8::gemm_phase<pg8::EpiAny<0, 0>, pg8::StaticOrder, true, true>(lds, g, S, E); }
    xcd_barrier(bar);
    { WS_SETUP TID_SETUP
            for (int T = gw; T < 8192; T += NGW) {
                const int b = T >> 10, h = (T >> 6) & 15, qb = T & 63;
                AttnArgs a; f32x16 o[2]; float lse2;
                a.q0 = qb * 32; a.kt_hi = qb; a.kt_lo = 0; a.rmax = 1 << 30; a.slope2 = 0.f; a.sink2 = -INFINITY;
                const h16* base = H2 + (size_t)(b * SEQ) * ODD_INP + h * 64;
                a.q = base; a.k = base + 1024; a.v = base + 2048; a.qstride = a.kstride = a.vstride = ODD_INP; a.k2 = nullptr; a.k2stride = 0; a.c1 = 0.125f;
                attn_task<4, true>(a, wlds, lane, o, lse2);
                store_o16(o, Y2 + (size_t)(b * SEQ + a.q0 + (lane & 31)) * DM + h * 64, lane >> 5);
            }
            __syncthreads();
            mla_phase(Q2, KV, KR, Y2, lds, G);
    }
    xcd_barrier(bar);
    { WS_SETUP pg8::Gemm g{Y2, (const h16*)(ws + WS_W_OOUT), MTOK, DM, DM}; pg8::EpiAny<2, 1> E{}; E.xbase = XR; E.ldc = DM; E.alpha = ALPHA; E.st_in = STATS + 2 * MTOK; E.g = P.in[14]; E.b = P.in[15]; E.xb = KV  ; E.st_out = STATS + 4 * MTOK;
      pg8::StaticOrder S; S.init(MTOK, DM, G, (int)blockIdx.x, WGM_N2048);
      pg8::gemm_phase<pg8::EpiAny<2, 1>, pg8::StaticOrder, true, true>(lds, g, S, E); }
    xcd_barrier(bar);
    { WS_SETUP pg8::Gemm g{KV, (const h16*)(ws + WS_W_W1B), MTOK, DFF, DM}; pg8::EpiAny<1, 1> E{}; E.O = HID; E.ldc = DFF; E.st_in = STATS + 4 * MTOK; E.c1 = C1 + 12288; E.c2 = C2 + 12288;
      pg8::StaticOrder S; S.init(MTOK, DFF, G, (int)blockIdx.x, WGM_UP);
      pg8::gemm_phase<pg8::EpiAny<1, 1>, pg8::StaticOrder, true, true>(lds, g, S, E); }
    xcd_barrier(bar);
    { WS_SETUP pg8::Gemm g{HID, (const h16*)(ws + WS_W_W2B), MTOK, DM, DFF}; pg8::EpiAny<2, 3> E{}; E.xbase = KV; E.xb = XB  ; E.ldc = DM; E.alpha = ALPHA; E.st_in = STATS + 4 * MTOK; E.g = P.in[10] + DM; E.b = P.in[11] + DM;
      pg8::StaticOrder S; S.init(MTOK, DM, G, (int)blockIdx.x, WGM_N2048, 4);
      pg8::gemm_phase<pg8::EpiAny<2, 3>, pg8::StaticOrder, true, true>(lds, g, S, E); }
    xcd_barrier(bar);
    { WS_SETUP TID_SETUP ln_final(XB, R, P.in[14] + 1 * DM, P.in[15] + 1 * DM, gw, NGW, lane); }
}

#undef x_in
#undef XB
#undef HID
#undef H
#undef Y
#undef H2
#undef CQN
#undef CKVN
#undef KR
#undef Q2
#undef KV
#undef Y2
#undef ROPE
#undef STATS
#undef C1
#undef C2
#undef PO
#undef LSE
#undef XR
extern "C" void kernel_launch(void* const* d_in, const int* in_sizes, int n_in, void* d_out, int out_size, void* d_ws, size_t ws_size, hipStream_t stream) {
    constexpr int LDS_BYTES = 147456;
    static int grid = 0;
    if (grid == 0) {
        if (n_in != 16 || in_sizes[0] != MTOK * DM || out_size != MTOK * DM || ws_size < WS_END) {
            fprintf(stderr, "kernel_launch: unexpected shapes: n_in %d in0 %d out %d ws %zu (need %zu)\n", n_in, n_in > 0 ? in_sizes[0] : -1, out_size, ws_size, (size_t)WS_END); grid = -1; return; }
        int dev = 0, cus = 0, per_cu = 0;
        if (hipGetDevice(&dev) != hipSuccess || hipDeviceGetAttribute(&cus, hipDeviceAttributeMultiprocessorCount, dev) != hipSuccess) { grid = -1; return; }
        if (hipFuncSetAttribute((const void*)mega_fwd, hipFuncAttributeMaxDynamicSharedMemorySize, LDS_BYTES) != hipSuccess) { fprintf(stderr, "kernel_launch: hipFuncSetAttribute failed\n"); grid = -1; return; }
        if (hipOccupancyMaxActiveBlocksPerMultiprocessor(&per_cu, (const void*)mega_fwd, NWAVES * 64, LDS_BYTES) != hipSuccess || per_cu < 1) { fprintf(stderr, "kernel_launch: occupancy query says %d\n", per_cu); per_cu = 1; }
        (void)hipGetLastError();
        grid = cus * per_cu;
    }
    if (grid < 0) return;
    Params p{};
    for (int i = 0; i < 16; ++i) p.in[i] = (const float*)d_in[i];
    p.out = (float*)d_out; p.ws = (unsigned char*)d_ws;
    if (hipMemsetAsync((char*)d_ws + WS_BAR, 0, 16384, stream) != hipSuccess) { fprintf(stderr, "kernel_launch: memset of the barrier words failed\n"); return; }
    void* args[] = {&p};
    hipError_t e = hipLaunchCooperativeKernel((const void*)mega_fwd, dim3(grid), dim3(NWAVES * 64), args, LDS_BYTES, stream);
    if (e != hipSuccess) fprintf(stderr, "kernel_launch: cooperative launch failed: %s (grid %d)\n", hipGetErrorString(e), grid);
}
```

```cpp
#include <hip/hip_runtime.h>
#include <hip/hip_cooperative_groups.h>
#include <cstdio>
#include <cstdint>
#include <cmath>
namespace cg = cooperative_groups;
#ifndef WGM_N2048
#define WGM_N2048 4
#endif
#ifndef WGM_UP
#define WGM_UP 4
#endif
#ifndef WGM_IN
#define WGM_IN 4
#endif
#ifndef WGM_SMALL
#define WGM_SMALL 2
#endif
namespace pg8 {
#define PG8_LAS __attribute__((address_space(3)))
typedef unsigned short bf16_t;
typedef _Float16 bf16x8 __attribute__((ext_vector_type(8)));
typedef float f32x4 __attribute__((ext_vector_type(4)));
typedef unsigned u32x4 __attribute__((ext_vector_type(4)));
constexpr int BM = 256, BK = 64, HALF = 128, HTB = HALF * BK * 2  , STAGE_BYTES = 8 * HTB, NXCD = 8, WGM = 8;

__host__ __device__ __forceinline__ int lds_byte(int r, int c) { const int st = (r >> 4) * 2 + (c >> 5), rr = r & 15, cc = c & 31, ob = rr * 64 + cc * 2; return st * 1024 + (ob ^ (((ob >> 9) & 1) << 5)); }
__host__ __device__ __forceinline__ void stage_rc(int b, int& R, int& C) { const int st = b / 1024, sb = b % 1024, swz = sb ^ (((sb >> 9) & 1) << 5); R = (st >> 1) * 16 + swz / 64; C = (st & 1) * 32 + (swz % 64) / 2; }
__host__ __device__ __forceinline__ int perm32(int rho) { const int n = rho >> 4, i = rho & 15; return 8 * (i >> 2) + 4 * n + (i & 3); }

struct Unit { int pm, pn; };
struct Gemm { const bf16_t* A; const bf16_t* Bt; int M, N, K; };

struct StaticOrder {
    int nM, nN, nwg, G, c, wgm, flip;
    __host__ __device__ void init(int M, int N, int G_, int c_, int wgm_ = 4, int flip_ = 0) { nM = M / BM; nN = N / BM; nwg = nM * nN; G = G_; c = c_; wgm = wgm_; flip = flip_; }
    __host__ __device__ bool next(int i, Unit& u) const {
        const long L = (long)i * G + c; if (L >= nwg) return false;
        int wgid = (int)L; { const int q = nwg / NXCD, r = nwg % NXCD, xcd = wgid % NXCD, off = wgid / NXCD; wgid = (xcd < r ? xcd * (q + 1) : r * (q + 1) + (xcd - r) * q) + off; }
        const int nig = wgm * nN, gid = wgid / nig, fm = gid * wgm, gsz = (nM - fm) < wgm ? (nM - fm) : wgm;
        u.pm = (fm + ((wgid % nig) % gsz)) ^ flip; u.pn = (wgid % nig) / gsz; return true;
    }
    __device__ __forceinline__ void a_ready(const Unit&) const {}
    __device__ __forceinline__ void done(const Unit&) const {}
};


typedef unsigned u32x2 __attribute__((ext_vector_type(2)));
__device__ __forceinline__ unsigned pk16(float lo, float hi) {
    typedef _Float16 h2_t __attribute__((ext_vector_type(2)));
    h2_t v; v.x = (_Float16)lo; v.y = (_Float16)hi; return __builtin_bit_cast(unsigned, v);
}
template <int KIND, int F> struct EpiAny {
    static constexpr bool AFTER_DRAIN = false; static constexpr int kind = KIND; static constexpr bool perm = (KIND <= 2);
    bf16_t* O; int ldc;
    const float* base; float* out; float alpha;
    const float* rope;
    const float* st_in; float* st_out;
    bf16_t* xb; const bf16_t* xbase;
    const float* g; const float* b;
    const float* c1; const float* c2;
    __device__ __forceinline__ void row_stats(int row, float& mean, float& rstd) const {
        const float s1 = st_in[2 * row], s2 = st_in[2 * row + 1]; mean = s1 * (1.f / 2048.f);
        const float var = fmaxf(s2 * (1.f / 2048.f) - mean * mean, 0.f); rstd = __builtin_amdgcn_rsqf(var + 1e-5f); }
    __device__ __forceinline__ void operator()(const f32x4 (&acc)[2][2][4][2], const Unit& u, int wr, int wc, int fr, int fq) const {
        const int row0 = u.pm * BM + wr * 64 + fr;
        if (kind <= 1) {
            const int col0 = u.pn * BM + wc * 32 + 8 * fq;
            f32x4 c1v[2][2], c2v[2][2];
            if (F == 1) {
#pragma unroll
                for (int bj = 0; bj < 2; ++bj)
#pragma unroll
                    for (int n = 0; n < 2; ++n) { c1v[bj][n] = *(const f32x4*)(c1 + col0 + bj * HALF + 4 * n); c2v[bj][n] = *(const f32x4*)(c2 + col0 + bj * HALF + 4 * n); } }
            float mean8[2][4], rstd8[2][4];
#pragma unroll
            for (int ai = 0; ai < 2; ++ai)
#pragma unroll
                for (int m = 0; m < 4; ++m) { mean8[ai][m] = 0.f; rstd8[ai][m] = 1.f; if (F == 1) row_stats(row0 + ai * HALF + m * 16, mean8[ai][m], rstd8[ai][m]); }
#pragma unroll
            for (int ai = 0; ai < 2; ++ai)
#pragma unroll
                for (int m = 0; m < 4; ++m) { const int row = row0 + ai * HALF + m * 16; bf16_t* rowp = O + (size_t)row * ldc + col0;
                    const float mean = mean8[ai][m], rstd = rstd8[ai][m];
#pragma unroll
                    for (int bj = 0; bj < 2; ++bj) { f32x4 v0 = acc[ai][bj][m][0], v1 = acc[ai][bj][m][1];
                        if (F == 1) { v0 = (v0 - c1v[bj][0] * mean) * rstd + c2v[bj][0]; v1 = (v1 - c1v[bj][1] * mean) * rstd + c2v[bj][1]; }
                        if (kind == 1) {
#pragma unroll
                            for (int e = 0; e < 4; ++e) { float a = fmaxf(v0[e], 0.f), b_ = fmaxf(v1[e], 0.f); v0[e] = a * a; v1[e] = b_ * b_; } }
                        u32x4 w; w.x = pk16(v0[0], v0[1]); w.y = pk16(v0[2], v0[3]); w.z = pk16(v1[0], v1[1]); w.w = pk16(v1[2], v1[3]);
                        *(u32x4*)(rowp + bj * HALF) = w; } }
        } else if (kind == 2) {
            const int col0 = u.pn * BM + wc * 32 + 8 * fq;
            typedef _Float16 h8_t __attribute__((ext_vector_type(8)));
#pragma unroll
            for (int ai = 0; ai < 2; ++ai) {
                f32x4 gv[2][2], bv[2][2];
#pragma unroll
                for (int bj = 0; bj < 2; ++bj)
#pragma unroll
                    for (int n = 0; n < 2; ++n) { gv[bj][n] = (f32x4){1.f, 1.f, 1.f, 1.f}; bv[bj][n] = (f32x4){0.f, 0.f, 0.f, 0.f};
                        if (F >= 1) { gv[bj][n] = *(const f32x4*)(g + col0 + bj * HALF + 4 * n); bv[bj][n] = *(const f32x4*)(b + col0 + bj * HALF + 4 * n); } }
#pragma unroll
              for (int mp = 0; mp < 2; ++mp) {
                h8_t hb[4][2]; float mean4[4], rstd4[4];
#pragma unroll
                for (int m = 2 * mp; m < 2 * mp + 2; ++m) { const int row = row0 + ai * HALF + m * 16; const size_t off = (size_t)row * ldc + col0;
                    mean4[m] = 0.f; rstd4[m] = 1.f; if (F >= 1) row_stats(row, mean4[m], rstd4[m]);
#pragma unroll
                    for (int bj = 0; bj < 2; ++bj) hb[m][bj] = *(const h8_t*)(xbase + off + bj * HALF); }
#pragma unroll
                for (int m = 2 * mp; m < 2 * mp + 2; ++m) { const int row = row0 + ai * HALF + m * 16; const size_t off = (size_t)row * ldc + col0;
                    const float mean = mean4[m], rstd = rstd4[m];
                    float s1 = 0.f, s2 = 0.f;
#pragma unroll
                    for (int bj = 0; bj < 2; ++bj) { const size_t o2 = off + bj * HALF; const h8_t hv = hb[m][bj];
                        f32x4 b0 = (f32x4){(float)hv[0], (float)hv[1], (float)hv[2], (float)hv[3]}, b1 = (f32x4){(float)hv[4], (float)hv[5], (float)hv[6], (float)hv[7]};
                        if (F >= 1) { b0 = (b0 - mean) * rstd * gv[bj][0] + bv[bj][0]; b1 = (b1 - mean) * rstd * gv[bj][1] + bv[bj][1]; }
                        const f32x4 r0 = b0 * alpha + acc[ai][bj][m][0], r1 = b1 * alpha + acc[ai][bj][m][1];
                        if (F <= 1 || F == 3) { u32x4 w; w.x = pk16(r0[0], r0[1]); w.y = pk16(r0[2], r0[3]); w.z = pk16(r1[0], r1[1]); w.w = pk16(r1[2], r1[3]); *(u32x4*)(xb + o2) = w;
                            s1 += ((r0[0] + r0[1]) + (r0[2] + r0[3])) + ((r1[0] + r1[1]) + (r1[2] + r1[3]));
                            s2 += ((r0[0] * r0[0] + r0[1] * r0[1]) + (r0[2] * r0[2] + r0[3] * r0[3])) + ((r1[0] * r1[0] + r1[1] * r1[1]) + (r1[2] * r1[2] + r1[3] * r1[3])); }
                        else { *(f32x4*)(out + o2) = r0; *(f32x4*)(out + o2 + 4) = r1; } }
                    if (F <= 1) { s1 += __shfl_xor(s1, 16); s2 += __shfl_xor(s2, 16); s1 += __shfl_xor(s1, 32); s2 += __shfl_xor(s2, 32);
                        if (fq == 0) { __hip_atomic_fetch_add(st_out + 2 * row, s1, __ATOMIC_RELAXED, __HIP_MEMORY_SCOPE_AGENT); __hip_atomic_fetch_add(st_out + 2 * row + 1, s2, __ATOMIC_RELAXED, __HIP_MEMORY_SCOPE_AGENT); } } }
                asm volatile("" ::: "memory"); } }
        } else {
            f32x4 rc[2][4], rs[2][4];
#pragma unroll
            for (int ai = 0; ai < 2; ++ai)
#pragma unroll
                for (int m = 0; m < 4; ++m) { const int pos = (row0 + ai * HALF + m * 16) & 2047; rc[ai][m] = *(const f32x4*)(rope + pos * 32 + 4 * fq); rs[ai][m] = *(const f32x4*)(rope + pos * 32 + 16 + 4 * fq); }
#pragma unroll
            for (int ai = 0; ai < 2; ++ai)
#pragma unroll
                for (int m = 0; m < 4; ++m) { const int row = row0 + ai * HALF + m * 16;
#pragma unroll
                    for (int bj = 0; bj < 2; ++bj) { const int gb = u.pn * BM + bj * HALF + wc * 32; f32x4 a = acc[ai][bj][m][0], b_ = acc[ai][bj][m][1];
                        if (((gb >> 5) % 3) == 2) { const f32x4 c = rc[ai][m], s = rs[ai][m];
                            const f32x4 a2 = a * c - b_ * s, b2 = a * s + b_ * c; a = a2; b_ = b2; }
                        bf16_t* p = O + (size_t)row * ldc + gb + 4 * fq;
                        u32x2 w0, w1; w0.x = pk16(a[0], a[1]); w0.y = pk16(a[2], a[3]); w1.x = pk16(b_[0], b_[1]); w1.y = pk16(b_[2], b_[3]);
                        *(u32x2*)p = w0; *(u32x2*)(p + 16) = w1; }
                    asm volatile("" ::: "memory"); }
        }
    }
};

template <class Epi, class Sched, bool ALIGN_EPI = false, bool SP2 = false>
__device__ __forceinline__ void gemm_phase(PG8_LAS unsigned char* lds, const Gemm g, const Sched& S, const Epi& E) {
    int tid_ = threadIdx.x; asm volatile("" : "+v"(tid_));
    const int tid = tid_, wid = __builtin_amdgcn_readfirstlane(tid >> 6), lane = tid & 63, wr = wid >> 2, wc = wid & 3, fr = lane & 15, fq = lane >> 4;
    const int K = g.K, nt = K / BK;
    unsigned voffA[2], voffB[2];
#pragma unroll
    for (int i = 0; i < 2; ++i) { int R, C; stage_rc(tid * 16 + i * 8192, R, C); const int Rb = E.perm ? ((R & ~31) + perm32(R & 31)) : R;
        voffA[i] = (unsigned)(R * K + C) * 2u; voffB[i] = (unsigned)(Rb * K + C) * 2u; }
    const size_t kstep = (size_t)(BK * 2);
    const size_t hstep = (size_t)HALF * K * 2;
    const size_t tstep = 2 * hstep;
    const unsigned ldsw = (unsigned)wid * 1024u;
    const int aoff = lds_byte(wr * 64 + fr, fq * 8), boff = lds_byte(wc * 32 + fr, fq * 8);
#define PG8_SA(b, h) (((b) * 2 + (h)) * HTB)
#define PG8_SB(b, h) ((4 + (b) * 2 + (h)) * HTB)
#define PG8_STAGE(bufoff, gbase, voff) do { _Pragma("unroll") for (int _i = 0; _i < 2; ++_i) \
        __builtin_amdgcn_global_load_lds((const unsigned*)((const char*)(gbase) + (voff)[_i]), (PG8_LAS unsigned*)(lds + (bufoff) + ldsw + _i * 8192), 16, 0, 0); } while (0)
#define PG8_LDA(dst, b, h) do { _Pragma("unroll") for (int m = 0; m < 4; ++m) _Pragma("unroll") for (int k = 0; k < 2; ++k) dst[m][k] = *(const PG8_LAS bf16x8*)(lds + PG8_SA(b, h) + aoff + m * 2048 + k * 1024); } while (0)
#define PG8_LDB(dst, b, h) do { _Pragma("unroll") for (int n = 0; n < 2; ++n) _Pragma("unroll") for (int k = 0; k < 2; ++k) dst[n][k] = *(const PG8_LAS bf16x8*)(lds + PG8_SB(b, h) + boff + n * 2048 + k * 1024); } while (0)
#define PG8_MMA(ai, bj, At, Bt) do { __builtin_amdgcn_s_setprio(1); _Pragma("unroll") for (int m = 0; m < 4; ++m) _Pragma("unroll") for (int n = 0; n < 2; ++n) _Pragma("unroll") for (int k = 0; k < 2; ++k) \
        acc[ai][bj][m][n] = __builtin_amdgcn_mfma_f32_16x16x32_f16(Bt[n][k], At[m][k], acc[ai][bj][m][n], 0, 0, 0); __builtin_amdgcn_s_setprio(0); } while (0)
#define PG8_WAIT_V(n) asm volatile("s_waitcnt vmcnt(" #n ")" ::: "memory")
#define PG8_WAIT_L(n) asm volatile("s_waitcnt lgkmcnt(" #n ")" ::: "memory")
#define PG8_BAR __builtin_amdgcn_s_barrier()
#define PG8_SCHED __builtin_amdgcn_sched_barrier(0)
    Unit cur, nxt; int ui = 0;
    if (!S.next(0, cur)) return;
    f32x4 acc[2][2][4][2];
#pragma unroll
    for (int a = 0; a < 2; ++a)
#pragma unroll
        for (int b = 0; b < 2; ++b)
#pragma unroll
            for (int m = 0; m < 4; ++m)
#pragma unroll
                for (int n = 0; n < 2; ++n) acc[a][b][m][n] = (f32x4){0.f, 0.f, 0.f, 0.f};
    bf16x8 At[4][2], B0[2][2], B1[2][2];
    const char* cA = (const char*)g.A + (size_t)cur.pm * tstep; const char* cB = (const char*)g.Bt + (size_t)cur.pn * tstep;
    S.a_ready(cur);
    if constexpr (SP2) {
        PG8_STAGE(PG8_SB(0, 0), cB, voffB); PG8_STAGE(PG8_SB(0, 1), cB + hstep, voffB); PG8_STAGE(PG8_SA(0, 0), cA, voffA); PG8_STAGE(PG8_SA(0, 1), cA + hstep, voffA);
        if (wr == 1) PG8_BAR;
        PG8_WAIT_V(2); PG8_BAR;
        PG8_STAGE(PG8_SB(1, 0), cB + kstep, voffB); PG8_STAGE(PG8_SA(1, 0), cA + kstep, voffA); PG8_STAGE(PG8_SB(1, 1), cB + hstep + kstep, voffB);
        PG8_WAIT_V(6); PG8_BAR;
    } else {
        PG8_STAGE(PG8_SB(0, 0), cB, voffB); PG8_STAGE(PG8_SA(0, 0), cA, voffA); PG8_STAGE(PG8_SB(0, 1), cB + hstep, voffB); PG8_STAGE(PG8_SA(0, 1), cA + hstep, voffA);
        if (wr == 1) PG8_BAR;
        PG8_WAIT_V(4); PG8_BAR;
        PG8_STAGE(PG8_SB(1, 0), cB + kstep, voffB); PG8_STAGE(PG8_SA(1, 0), cA + kstep, voffA); PG8_STAGE(PG8_SB(1, 1), cB + hstep + kstep, voffB);
        PG8_WAIT_V(6); PG8_BAR;
    }
    for (;;) {
        const bool has_next = S.next(ui + 1, nxt);
        const char* nA = has_next ? (const char*)g.A + (size_t)nxt.pm * tstep : cA; const char* nB = has_next ? (const char*)g.Bt + (size_t)nxt.pn * tstep : cB;
        for (int t = 0; t < nt; t += 2) {
            const bool last = (t == nt - 2);
            const char* a1 = cA + (size_t)(t + 1) * kstep;
            const char* a2 = last ? nA : cA + (size_t)(t + 2) * kstep; const char* b2 = last ? nB : cB + (size_t)(t + 2) * kstep;
            const char* a3 = a2 + kstep; const char* b3 = b2 + kstep;
            if (last && has_next) S.a_ready(nxt);
            if constexpr (SP2) {
            PG8_LDB(B0, 0, 0); PG8_LDB(B1, 0, 1); PG8_SCHED; PG8_LDA(At, 0, 0); PG8_STAGE(PG8_SA(1, 1), a1 + hstep, voffA);
            PG8_WAIT_V(8); PG8_WAIT_L(0); PG8_BAR; PG8_MMA(0, 0, At, B0); PG8_MMA(0, 1, At, B1); PG8_BAR; PG8_SCHED;
            PG8_LDA(At, 0, 1); PG8_STAGE(PG8_SB(0, 0), b2, voffB); PG8_STAGE(PG8_SB(0, 1), b2 + hstep, voffB); PG8_STAGE(PG8_SA(0, 0), a2, voffA);
            PG8_WAIT_V(8); PG8_WAIT_L(0); PG8_BAR; PG8_MMA(1, 0, At, B0); PG8_MMA(1, 1, At, B1); PG8_BAR; PG8_SCHED;
            PG8_LDB(B0, 1, 0); PG8_LDB(B1, 1, 1); PG8_SCHED; PG8_LDA(At, 1, 0); PG8_STAGE(PG8_SA(0, 1), a2 + hstep, voffA);
            PG8_WAIT_V(8); PG8_WAIT_L(0); PG8_BAR; PG8_MMA(0, 0, At, B0); PG8_MMA(0, 1, At, B1); PG8_BAR; PG8_SCHED;
            PG8_LDA(At, 1, 1); PG8_STAGE(PG8_SB(1, 0), b3, voffB); PG8_STAGE(PG8_SB(1, 1), b3 + hstep, voffB); PG8_STAGE(PG8_SA(1, 0), a3, voffA);
            PG8_WAIT_V(8); PG8_WAIT_L(0); PG8_BAR; PG8_MMA(1, 0, At, B0); PG8_MMA(1, 1, At, B1); PG8_BAR; PG8_SCHED;
            } else {
            PG8_LDB(B0, 0, 0); PG8_SCHED; PG8_LDA(At, 0, 0); PG8_STAGE(PG8_SA(1, 1), a1 + hstep, voffA);
            PG8_WAIT_L(8); PG8_BAR; PG8_WAIT_L(0); PG8_MMA(0, 0, At, B0); PG8_BAR; PG8_SCHED;
            PG8_LDB(B1, 0, 1); PG8_STAGE(PG8_SB(0, 0), b2, voffB);
            PG8_BAR; PG8_WAIT_L(0); PG8_MMA(0, 1, At, B1); PG8_BAR;
            PG8_LDA(At, 0, 1); PG8_STAGE(PG8_SA(0, 0), a2, voffA);
            PG8_BAR; PG8_WAIT_L(0); PG8_MMA(1, 0, At, B0); PG8_BAR; PG8_SCHED;
            PG8_STAGE(PG8_SB(0, 1), b2 + hstep, voffB);
            PG8_WAIT_V(6); PG8_BAR; PG8_MMA(1, 1, At, B1); PG8_BAR;
            PG8_LDB(B0, 1, 0); PG8_SCHED; PG8_LDA(At, 1, 0); PG8_STAGE(PG8_SA(0, 1), a2 + hstep, voffA);
            PG8_WAIT_L(8); PG8_BAR; PG8_WAIT_L(0); PG8_MMA(0, 0, At, B0); PG8_BAR; PG8_SCHED;
            PG8_LDB(B1, 1, 1); PG8_STAGE(PG8_SB(1, 0), b3, voffB);
            PG8_BAR; PG8_WAIT_L(0); PG8_MMA(0, 1, At, B1); PG8_BAR;
            PG8_LDA(At, 1, 1); PG8_STAGE(PG8_SA(1, 0), a3, voffA);
            PG8_BAR; PG8_WAIT_L(0); PG8_MMA(1, 0, At, B0); PG8_BAR; PG8_SCHED;
            PG8_STAGE(PG8_SB(1, 1), b3 + hstep, voffB);
            PG8_WAIT_V(6); PG8_BAR; PG8_MMA(1, 1, At, B1); PG8_BAR;
            }
        }
        if constexpr (ALIGN_EPI) { if (wr == 0) PG8_BAR; }
        if constexpr (!Epi::AFTER_DRAIN) { E(acc, cur, wr, wc, fr, fq); S.done(cur); }
        if (!has_next) break;
#pragma unroll
        for (int a = 0; a < 2; ++a)
#pragma unroll
            for (int b = 0; b < 2; ++b)
#pragma unroll
                for (int m = 0; m < 4; ++m)
#pragma unroll
                    for (int n = 0; n < 2; ++n) acc[a][b][m][n] = (f32x4){0.f, 0.f, 0.f, 0.f};
        cur = nxt; cA = nA; cB = nB; ++ui;
        if constexpr (ALIGN_EPI) { if (wr == 1) PG8_BAR; }
    }
    PG8_WAIT_V(0);
    if constexpr (!ALIGN_EPI) { if (wr == 0) PG8_BAR; }
    PG8_BAR;
    if constexpr (Epi::AFTER_DRAIN) { E.fused(acc, cur, wr, wc, fr, fq, lds, wid, lane); S.done(cur); }
#undef PG8_SA
#undef PG8_SB
#undef PG8_STAGE
#undef PG8_LDA
#undef PG8_LDB
#undef PG8_MMA
#undef PG8_WAIT_V
#undef PG8_WAIT_L
#undef PG8_BAR
#undef PG8_SCHED
}
}

#define LAS __attribute__((address_space(3)))
typedef unsigned short h16;
typedef _Float16 h8 __attribute__((ext_vector_type(8)));
typedef _Float16 h4 __attribute__((ext_vector_type(4)));
typedef float f32x4 __attribute__((ext_vector_type(4)));
typedef float f32x16 __attribute__((ext_vector_type(16)));
typedef unsigned u32x4 __attribute__((ext_vector_type(4)));
typedef unsigned u32x2 __attribute__((ext_vector_type(2)));
typedef short v4i16_t __attribute__((ext_vector_type(4)));
using pg8::pk16;

constexpr int SEQ = 2048, DM = 2048, MTOK = 16384, DFF = 8192;
constexpr int EVEN_IN = 5888, EVEN_OUT = 1536, ODD_IN = 3872, ODD_INP = 4096, UQ_N = 1536, UKV_N = 2048;
constexpr float LN_EPS = 1e-5f, RMS_EPS = 1e-6f;
constexpr float ALPHA = 1.41421356237309515f;
constexpr float LOG2E = 1.4426950408889634f, LN2 = 0.6931471805599453f;
constexpr int NWAVES = 8;

constexpr size_t MiB = 1u << 20;
constexpr size_t WS_BAR = 0;
constexpr size_t WS_STATS = 64 * 1024;
constexpr size_t WS_C12 = 512 * 1024;
constexpr size_t WS_ROPE = 1 * MiB;
constexpr size_t WS_W_OIN = 2 * MiB, WS_W_UQ = 18 * MiB, WS_W_UKV = 20 * MiB, WS_W_OOUT = 21 * MiB, WS_W_W1B = 29 * MiB, WS_W_W2B = 61 * MiB;
constexpr size_t WS_W_EIN = 93 * MiB, WS_W_EOUT = 116 * MiB, WS_W_W1A = 122 * MiB, WS_W_W2A = 154 * MiB;
constexpr size_t WS_XB = 186 * MiB;
constexpr size_t WS_HID = 250 * MiB;
constexpr size_t WS_H = WS_HID, WS_Y = WS_HID + 184 * MiB;
constexpr size_t WS_H2 = WS_HID, WS_CQN = WS_HID + 128 * MiB, WS_CKVN = WS_HID + 144 * MiB, WS_KR = WS_HID + 152 * MiB, WS_Q2 = WS_HID + 153 * MiB;
constexpr size_t WS_KV = 93 * MiB;
constexpr size_t WS_Y2 = WS_XB;
constexpr size_t WS_END = 506 * MiB;
constexpr size_t OUT_PO = 0, OUT_LSE = (size_t)3 * MTOK * 512;

struct Params { const float* in[16]; float* out; unsigned char* ws; };

__device__ __forceinline__ float wave_sum(float v) {
#pragma unroll
    for (int o = 1; o < 64; o <<= 1) v += __shfl_xor(v, o);
    return v;
}

__device__ __forceinline__ void transpose_item(const float* W, int K, int N, h16* WT, int item, LAS float* scr, int lane) {
    const int nblk = N / 32, kb = item / nblk, nb = item % nblk, k0 = 64 * kb, n0 = 32 * nb;
#pragma unroll
    for (int i = 0; i < 32; ++i) { const int kk = 2 * i + (lane >> 5); scr[kk * 33 + (lane & 31)] = W[(size_t)(k0 + kk) * N + n0 + (lane & 31)]; }
    asm volatile("s_waitcnt lgkmcnt(0)" ::: "memory");
    const int c = lane & 7;
#pragma unroll
    for (int j = 0; j < 4; ++j) { const int n = (lane >> 3) + 8 * j; const LAS float* s = scr + (8 * c) * 33 + n;
        u32x4 o; o.x = pk16(s[0 * 33], s[1 * 33]); o.y = pk16(s[2 * 33], s[3 * 33]); o.z = pk16(s[4 * 33], s[5 * 33]); o.w = pk16(s[6 * 33], s[7 * 33]);
        *(u32x4*)(WT + (size_t)(n0 + n) * K + k0 + 8 * c) = o; }
    asm volatile("s_waitcnt lgkmcnt(0)" ::: "memory");
}

__device__ __forceinline__ void transpose_item_fold(const float* W, int K, int N, h16* WT, int item, LAS float* scr, int lane, const float* g, const float* b, float* c1, float* c2) {
    const int nblk = N / 32, kb = item / nblk, nb = item % nblk, k0 = 64 * kb, n0 = 32 * nb;
    float a1 = 0.f, a2 = 0.f;
#pragma unroll
    for (int i = 0; i < 32; ++i) { const int kk = 2 * i + (lane >> 5); const float w = W[(size_t)(k0 + kk) * N + n0 + (lane & 31)]; const float wg = w * g[k0 + kk];
        scr[kk * 33 + (lane & 31)] = wg; a1 += (float)(_Float16)wg; a2 += b[k0 + kk] * w; }
    a1 += __shfl_xor(a1, 32); a2 += __shfl_xor(a2, 32);
    if (lane < 32) { __hip_atomic_fetch_add(c1 + n0 + lane, a1, __ATOMIC_RELAXED, __HIP_MEMORY_SCOPE_AGENT); __hip_atomic_fetch_add(c2 + n0 + lane, a2, __ATOMIC_RELAXED, __HIP_MEMORY_SCOPE_AGENT); }
    asm volatile("s_waitcnt lgkmcnt(0)" ::: "memory");
    const int c = lane & 7;
#pragma unroll
    for (int j = 0; j < 4; ++j) { const int n = (lane >> 3) + 8 * j; const LAS float* s = scr + (8 * c) * 33 + n;
        u32x4 o; o.x = pk16(s[0 * 33], s[1 * 33]); o.y = pk16(s[2 * 33], s[3 * 33]); o.z = pk16(s[4 * 33], s[5 * 33]); o.w = pk16(s[6 * 33], s[7 * 33]);
        *(u32x4*)(WT + (size_t)(n0 + n) * K + k0 + 8 * c) = o; }
    asm volatile("s_waitcnt lgkmcnt(0)" ::: "memory");
}

__device__ __forceinline__ void sincos_d(double a, double& s, double& c) {
    const double k = __builtin_rint(a * 0.63661977236758134308);
    const double y = (a - k * 1.57079632679489655800) - k * 6.12323399573676603587e-17;
    const double y2 = y * y;
    double sp = -7.6471637318198164759e-13;
    sp = sp * y2 + 1.6059043836821614599e-10; sp = sp * y2 - 2.5052108385441718775e-08; sp = sp * y2 + 2.7557319223985890653e-06;
    sp = sp * y2 - 1.9841269841269841270e-04; sp = sp * y2 + 8.3333333333333332177e-03; sp = sp * y2 - 1.6666666666666665741e-01;
    const double sy = y + y * y2 * sp;
    double cp = 4.7794773323873852974e-14;
    cp = cp * y2 - 1.1470745597729724714e-11; cp = cp * y2 + 2.0876756987868098979e-09; cp = cp * y2 - 2.7557319223985888276e-07;
    cp = cp * y2 + 2.4801587301587301566e-05; cp = cp * y2 - 1.3888888888888889419e-03; cp = cp * y2 + 4.1666666666666664354e-02; cp = cp * y2 - 0.5;
    const double cy = 1.0 + y2 * cp;
    const int q = ((int)k) & 3;
    s = (q == 0) ? sy : (q == 1) ? cy : (q == 2) ? -sy : -cy;
    c = (q == 0) ? cy : (q == 1) ? -sy : (q == 2) ? -cy : sy;
}

__device__ __forceinline__ void ln_pass(float* R, h16* XB, const float* g, const float* b, bool write_h, int gw, int NGW, int lane) {
    for (int row = gw; row < MTOK; row += NGW) {
        f32x4* rp = (f32x4*)(R + (size_t)row * DM) + lane;
        f32x4 v[8]; float s = 0.f;
#pragma unroll
        for (int j = 0; j < 8; ++j) { v[j] = rp[64 * j]; s += (v[j].x + v[j].y) + (v[j].z + v[j].w); }
        const float mean = wave_sum(s) * (1.f / DM); float s2 = 0.f;
#pragma unroll
        for (int j = 0; j < 8; ++j) { v[j] = v[j] - mean; s2 += (v[j].x * v[j].x + v[j].y * v[j].y) + (v[j].z * v[j].z + v[j].w * v[j].w); }
        const float rstd = 1.f / sqrtf(wave_sum(s2) * (1.f / DM) + LN_EPS);
        u32x2* xp = (u32x2*)(XB + (size_t)row * DM) + lane;
#pragma unroll
        for (int j = 0; j < 8; ++j) {
            const f32x4 gg = ((const f32x4*)g)[64 * j + lane], bb = ((const f32x4*)b)[64 * j + lane];
            const f32x4 y = v[j] * rstd * gg + bb;
            rp[64 * j] = y;
            if (write_h) { u32x2 w; w.x = pk16(y.x, y.y); w.y = pk16(y.z, y.w); xp[64 * j] = w; }
        }
    }
}

__device__ __forceinline__ void ln_final(const h16* X, float* out, const float* g, const float* b, int gw, int NGW, int lane) {
    for (int row = gw; row < MTOK; row += NGW) {
        const h8* xp = (const h8*)(X + (size_t)row * DM) + lane;
        float v[4][8]; float s = 0.f;
#pragma unroll
        for (int j = 0; j < 4; ++j) { const h8 hv = __builtin_nontemporal_load(xp + 64 * j);
#pragma unroll
            for (int e = 0; e < 8; ++e) { v[j][e] = (float)hv[e]; s += v[j][e]; } }
        const float mean = wave_sum(s) * (1.f / DM); float s2 = 0.f;
#pragma unroll
        for (int j = 0; j < 4; ++j)
#pragma unroll
            for (int e = 0; e < 8; ++e) { v[j][e] -= mean; s2 += v[j][e] * v[j][e]; }
        const float rstd = 1.f / sqrtf(wave_sum(s2) * (1.f / DM) + LN_EPS);
#pragma unroll
        for (int j = 0; j < 4; ++j) { const int c0 = (64 * j + lane) * 8;
            const f32x4 g0 = *(const f32x4*)(g + c0), g1 = *(const f32x4*)(g + c0 + 4), b0 = *(const f32x4*)(b + c0), b1 = *(const f32x4*)(b + c0 + 4);
            const f32x4 y0 = (f32x4){v[j][0], v[j][1], v[j][2], v[j][3]} * rstd * g0 + b0, y1 = (f32x4){v[j][4], v[j][5], v[j][6], v[j][7]} * rstd * g1 + b1;
            __builtin_nontemporal_store(y0, (f32x4*)(out + (size_t)row * DM + c0)); __builtin_nontemporal_store(y1, (f32x4*)(out + (size_t)row * DM + c0 + 4)); }
    }
}

struct AttnArgs {
    const h16* q; long qstride;
    const h16* k; long kstride;
    const h16* k2; long k2stride;
    const h16* v; long vstride;
    int q0;
    int kt_lo, kt_hi;
    int rmax;
    float c1;
    float slope2;
    float sink2;
};
__device__ __forceinline__ int crow_off(int r) { return (r & 3) + 8 * (r >> 2); }

template <bool SB>
__device__ __forceinline__ int attn_tile(const h8 (&qf)[4], LAS unsigned char* kl, LAS unsigned char* vrd, int r32, int hi, int relb, int D, int rmax, float c1, float slope2,
                                         f32x16 (&o)[2], float& m, float& l, float& carry) {
    constexpr int VP = 144, KP = 144;
    f32x16 s;
#pragma unroll
    for (int r = 0; r < 16; ++r) s[r] = 0.f;
#pragma unroll
    for (int c = 0; c < 4; ++c) { const h8 kf = *(const LAS h8*)(kl + r32 * KP + (16 * c + 8 * hi) * 2); s = __builtin_amdgcn_mfma_f32_32x32x16_f16(kf, qf[c], s, 0, 0, 0); }
    float t[16]; int done = 0;
    if (!SB) {
        const float bb = -slope2 * (float)relb;
        float mt = -INFINITY;
        if (D == 0 || D + 31 > rmax) {
#pragma unroll
            for (int r = 0; r < 16; ++r) { const int rel = relb - crow_off(r); float x = fmaf(s[r], c1, fmaf(slope2, (float)crow_off(r), bb));
                x = (rel >= 0 && rel <= rmax) ? x : -INFINITY; t[r] = x; mt = fmaxf(mt, x); }
        } else {
#pragma unroll
            for (int r = 0; r < 16; ++r) { const float x = fmaf(s[r], c1, fmaf(slope2, (float)crow_off(r), bb)); t[r] = x; mt = fmaxf(mt, x); }
        }
        mt = fmaxf(mt, __shfl_xor(mt, 32));
        const float mn = fmaxf(m, mt);
        const float al = __builtin_amdgcn_exp2f(m - mn);
        float ls = 0.f;
#pragma unroll
        for (int r = 0; r < 16; ++r) { t[r] = __builtin_amdgcn_exp2f(t[r] - mn); ls += t[r]; }
        ls += __shfl_xor(ls, 32);
        l = l * al + ls; m = mn;
        if (__any(al != 1.f)) {
#pragma unroll
            for (int r = 0; r < 16; ++r) { o[0][r] *= al; o[1][r] *= al; } }
    } else {
        float L[16], lb[16];
#pragma unroll
        for (int r = 0; r < 16; ++r) { const float z = s[r] * c1;
            const float e = __expf(-fabsf(z)); const float sp = fmaxf(z, 0.f) + __logf(1.f + e);
            lb[r] = z - sp;
            L[r] = sp; }
        if (D == 0) {
#pragma unroll
            for (int r = 0; r < 16; ++r) { const bool ok = (relb - crow_off(r)) >= 1; L[r] = ok ? L[r] : 0.f; lb[r] = ok ? lb[r] : -INFINITY; } }
        float gs[4], pg[4], tail[4];
#pragma unroll
        for (int g = 0; g < 4; ++g) { gs[g] = (L[4 * g] + L[4 * g + 1]) + (L[4 * g + 2] + L[4 * g + 3]); pg[g] = __shfl_xor(gs[g], 32); }
        float run = 0.f;
#pragma unroll
        for (int g = 3; g >= 0; --g) { tail[g] = (hi == 0) ? run + pg[g] : run; run += gs[g] + pg[g]; }
#pragma unroll
        for (int g = 0; g < 4; ++g) { float af = carry + tail[g];
#pragma unroll
            for (int e = 3; e >= 0; --e) { const int r = 4 * g + e; t[r] = __expf(lb[r] - af); af += L[r]; } }
        carry += run;
        done = __all(carry > 40.f);
    }
    h8 pk0, pk1;
#pragma unroll
    for (int j = 0; j < 8; ++j) { pk0[j] = (_Float16)t[j]; pk1[j] = (_Float16)t[8 + j]; }
#pragma unroll
    for (int d0 = 0; d0 < 2; ++d0)
#pragma unroll
        for (int ks = 0; ks < 2; ++ks) {
            const v4i16_t lo = __builtin_amdgcn_ds_read_tr16_b64_v4i16((LAS v4i16_t*)(vrd + (16 * ks) * VP + d0 * 64));
            const v4i16_t hh = __builtin_amdgcn_ds_read_tr16_b64_v4i16((LAS v4i16_t*)(vrd + (16 * ks + 8) * VP + d0 * 64));
            const h8 vf = __builtin_bit_cast(h8, __builtin_shufflevector(lo, hh, 0, 1, 2, 3, 4, 5, 6, 7));
            o[d0] = __builtin_amdgcn_mfma_f32_32x32x16_f16(vf, ks ? pk1 : pk0, o[d0], 0, 0, 0);
        }
    return done;
}

template <int NC, bool SB>
__device__ __forceinline__ void attn_task(const AttnArgs& a, LAS unsigned char* vl, int lane, f32x16 (&o)[2], float& lse2) {
    static_assert(NC == 4, "the per-wave task handles 64-wide heads");
    constexpr int VP = 144, KP = 144;
    const int r32 = lane & 31, hi = lane >> 5;
    h8 qf[4];
    { const h16* qp = a.q + (long)(a.q0 + r32) * a.qstride + 8 * hi;
#pragma unroll
      for (int c = 0; c < 4; ++c) qf[c] = *(const h8*)(qp + 16 * c); }
#pragma unroll
    for (int r = 0; r < 16; ++r) { o[0][r] = 0.f; o[1][r] = 0.f; }
    float m = a.sink2, l = (a.sink2 > -1e30f) ? 1.f : 0.f, carry = 0.f;
    const int vrow = lane >> 3, vcc = lane & 7;
    const int q4 = (lane & 15) >> 2, p4 = lane & 3, dblk = (lane >> 4) & 1;
    LAS unsigned char* vrd = vl + (4 * hi + q4) * VP + dblk * 32 + p4 * 8;
    LAS unsigned char* kl = vl + 32 * VP;
    u32x4 kA[4], vA[4], kB[4], vB[4];
#define ATT_LOADKV(KS, VS, kt_) do { const int k0_ = (kt_) * 32; \
        _Pragma("unroll") for (int i = 0; i < 4; ++i) KS[i] = *(const u32x4*)(a.k + (long)(k0_ + i * 8 + vrow) * a.kstride + 8 * vcc); \
        _Pragma("unroll") for (int i = 0; i < 4; ++i) VS[i] = *(const u32x4*)(a.v + (long)(k0_ + i * 8 + vrow) * a.vstride + 8 * vcc); } while (0)
#define ATT_STEP(KS, VS, kt_) do { asm volatile("" ::: "memory"); \
        _Pragma("unroll") for (int i = 0; i < 4; ++i) { *(LAS u32x4*)(kl + (i * 8 + vrow) * KP + vcc * 16) = KS[i]; *(LAS u32x4*)(vl + (i * 8 + vrow) * VP + vcc * 16) = VS[i]; } \
        asm volatile("" ::: "memory"); \
        { const int ktn_ = ((kt_) - 2 >= a.kt_lo) ? (kt_) - 2 : a.kt_lo; ATT_LOADKV(KS, VS, ktn_); }     \
        done = attn_tile<SB>(qf, kl, vrd, r32, hi, a.q0 + r32 - (kt_) * 32 - 4 * hi, a.q0 - (kt_) * 32, a.rmax, a.c1, a.slope2, o, m, l, carry); \
        asm volatile("" ::: "memory"); } while (0)
    int done = 0;
    ATT_LOADKV(kA, vA, a.kt_hi);
    { const int kt1 = (a.kt_hi - 1 >= a.kt_lo) ? a.kt_hi - 1 : a.kt_lo; ATT_LOADKV(kB, vB, kt1); }
    for (int kt = a.kt_hi; kt >= a.kt_lo; kt -= 2) {
        ATT_STEP(kA, vA, kt);
        if (SB && done) break;
        if (kt - 1 < a.kt_lo) break;
        ATT_STEP(kB, vB, kt - 1);
        if (SB && done) break;
    }
#undef ATT_LOADKV
#undef ATT_STEP
    if (!SB) {
        const float inv = 1.f / l;
#pragma unroll
        for (int r = 0; r < 16; ++r) { o[0][r] *= inv; o[1][r] *= inv; }
        lse2 = m + __log2f(l);
    } else lse2 = 0.f;
}
__device__ __forceinline__ void store_o16(const f32x16 (&o)[2], h16* orow, int hi) {
#pragma unroll
    for (int d0 = 0; d0 < 2; ++d0)
#pragma unroll
        for (int g = 0; g < 4; ++g) { u32x2 w; w.x = pk16(o[d0][4 * g], o[d0][4 * g + 1]); w.y = pk16(o[d0][4 * g + 2], o[d0][4 * g + 3]);
            *(u32x2*)(orow + 32 * d0 + 8 * g + 4 * hi) = w; }
}
__device__ __forceinline__ void store_o32(const f32x16 (&o)[2], float* orow, int hi) {
#pragma unroll
    for (int d0 = 0; d0 < 2; ++d0)
#pragma unroll
        for (int g = 0; g < 4; ++g) { f32x4 w = {o[d0][4 * g], o[d0][4 * g + 1], o[d0][4 * g + 2], o[d0][4 * g + 3]};
            *(f32x4*)(orow + 32 * d0 + 8 * g + 4 * hi) = w; }
}

struct ABUnit { int isA, b, h, g, d, res0, u, qb; };
__device__ __forceinline__ ABUnit ab_decode(int U) {
    ABUnit x; x.isA = U < 1024;
    if (x.isA) { x.b = U >> 7; x.h = (U >> 6) & 1; x.qb = U & 63; x.g = 0; x.d = 1; x.res0 = 0; x.u = 0; }
    else { const int V = (U - 1024) & 511; x.g = (U - 1024) >> 9; x.b = V >> 6; x.h = (V >> 3) & 7; x.qb = 0;
        if (x.g == 0) { x.d = 1; x.res0 = 0; x.u = V & 7; } else if (x.g == 1) { x.d = 4; x.res0 = (V >> 1) & 3; x.u = V & 1; } else { x.d = 16; x.res0 = 2 * (V & 7); x.u = 0; } }
    return x;
}
#define AB_BAR() asm volatile("s_waitcnt lgkmcnt(0)\n\ts_barrier" ::: "memory")
__device__ __forceinline__ void ab_phase(const h16* H, const float* sinks, h16* Y, h16* PO16, float* LSE, LAS unsigned char* lds, int G) {
    constexpr int SLOT = 9216, VP = 144, NU = 2560;
    int tid = threadIdx.x; asm volatile("" : "+v"(tid));
    const int lane = tid & 63, w = __builtin_amdgcn_readfirstlane(tid >> 6), r32 = lane & 31, hi = lane >> 5;
    const int isV = tid >> 8, lrow = (tid & 255) >> 3, lcc = tid & 7;
    const int q4 = (lane & 15) >> 2, p4 = lane & 3, dblk = (lane >> 4) & 1;
    const int vrd_off = (4 * hi + q4) * VP + dblk * 32 + p4 * 8;
    LAS unsigned char* wdst = lds + (isV ? 0 : 32 * VP) + lrow * VP + lcc * 16;
    u32x4 tr[12]; h8 qn[4];
#define AB_ISSUE(U_) do { const ABUnit x_ = ab_decode(U_); \
        const long stride_ = (long)x_.d * EVEN_IN; \
        const h16* kb0_ = x_.isA ? H + (size_t)(x_.b * SEQ) * EVEN_IN + 1024 + x_.h * 64 : H + (size_t)(x_.b * SEQ + x_.res0) * EVEN_IN + 1280 + x_.g * 1536 + x_.h * 64 + 512; \
        const int voff_ = x_.isA ? 128 : 512; \
        const h16* lp_ = kb0_ + (isV ? voff_ : 0) + (long)lrow * stride_ + 8 * lcc; \
        const int kt0_ = x_.isA ? x_.qb - 4 : (x_.d == 16 ? 0 : 8 * x_.u - 4), nt_ = x_.isA ? 5 : (x_.d == 16 ? 8 : 12); \
        _Pragma("unroll") for (int i = 0; i < 12; ++i) { const int kt_ = (x_.d == 16) ? (i & 3) : kt0_ + i; const int sg_ = (x_.d == 16) ? (i >> 2) : 0; \
            if (i < nt_ && kt_ >= 0) tr[i] = *(const u32x4*)(lp_ + (long)sg_ * EVEN_IN + (long)(32 * kt_) * stride_); } \
        { const int qbw_ = x_.isA ? x_.qb : (x_.d == 16 ? (w & 3) : 8 * x_.u + w); const int sgw_ = (x_.d == 16) ? (w >> 2) : 0; \
          const h16* qp_ = (x_.isA ? H + (size_t)(x_.b * SEQ) * EVEN_IN + (x_.h * 8 + w) * 64 : kb0_ - 512 + (long)sgw_ * EVEN_IN) + (long)(32 * qbw_ + r32) * stride_ + 8 * hi; \
          _Pragma("unroll") for (int c = 0; c < 4; ++c) qn[c] = *(const h8*)(qp_ + 16 * c); } } while (0)
    int U = ((gridDim.x % 8 == 0) ? (int)((blockIdx.x % 8) * (gridDim.x / 8) + blockIdx.x / 8) : (int)blockIdx.x);
    if (U < NU) AB_ISSUE(U);
    for (; U < NU; U += G) {
        AB_BAR();
#pragma unroll
        for (int i = 0; i < 12; ++i) *(LAS u32x4*)(wdst + i * SLOT) = tr[i];
        h8 qf[4];
#pragma unroll
        for (int c = 0; c < 4; ++c) qf[c] = qn[c];
        AB_BAR();
        if (U + G < NU) AB_ISSUE(U + G);
        const ABUnit x = ab_decode(U);
        const int qbw = x.isA ? x.qb : (x.d == 16 ? (w & 3) : 8 * x.u + w);
        const int slot0 = x.isA ? 4 : (x.d == 16 ? (w >> 2) * 4 + (w & 3) : w + 4);
        const int njt = qbw + 1 < 5 ? qbw + 1 : 5;
        const int hq = x.isA ? x.h * 8 + w : x.h;
        const float slope2 = x.isA ? __builtin_amdgcn_exp2f(-0.5f * (float)(hq + 1)) * LOG2E : __builtin_amdgcn_exp2f(-(float)(hq + 1)) * (float)x.d * LOG2E;
        const float sink2 = x.isA ? sinks[hq] * LOG2E : -INFINITY;
        const int rmax = x.isA ? 127 : 128;
        f32x16 o[2];
#pragma unroll
        for (int r = 0; r < 16; ++r) { o[0][r] = 0.f; o[1][r] = 0.f; }
        float m = sink2, l = x.isA ? 1.f : 0.f, carry = 0.f;
        for (int j = 0; j < njt; ++j) {
            LAS unsigned char* vl = lds + (slot0 - j) * SLOT;
            (void)attn_tile<false>(qf, vl + 32 * VP, vl + vrd_off, r32, hi, 32 * j + r32 - 4 * hi, 32 * j, rmax, 0.125f * LOG2E, slope2, o, m, l, carry);
        }
        const float inv = 1.f / l;
#pragma unroll
        for (int r = 0; r < 16; ++r) { o[0][r] *= inv; o[1][r] *= inv; }
        if (x.isA) store_o16(o, Y + (size_t)(x.b * SEQ + 32 * qbw + r32) * EVEN_OUT + hq * 64, hi);
        else { const int resw = x.res0 + ((x.d == 16) ? (w >> 2) : 0); const size_t tok = (size_t)(x.b * SEQ + resw + x.d * (32 * qbw + r32));
            store_o16(o, PO16 + ((size_t)x.g * MTOK + tok) * 512 + hq * 64, hi);
            if (lane < 32) LSE[((size_t)x.g * MTOK + tok) * 8 + hq] = (m + __log2f(l)) * LN2; }
    }
#undef AB_ISSUE
    AB_BAR();
}

__device__ __forceinline__ void mla_tile(LAS unsigned char* bb, int T, int dtile, int qrow0, int r32, int hi, int vrd_off, float c1, const h8 (&qf)[6], f32x16 (&o)[2], float& m, float& l) {
    constexpr int KP = 208, VP = 144, KBYTES = 64 * KP;
                if (2 * T <= dtile) {
                    f32x16 s0, s1;
#pragma unroll
                    for (int r = 0; r < 16; ++r) { s0[r] = 0.f; s1[r] = 0.f; }
#pragma unroll
                    for (int c = 0; c < 6; ++c) { const h8 kf0 = *(const LAS h8*)(bb + r32 * KP + (16 * c + 8 * hi) * 2), kf1 = *(const LAS h8*)(bb + (32 + r32) * KP + (16 * c + 8 * hi) * 2);
                        s0 = __builtin_amdgcn_mfma_f32_32x32x16_f16(kf0, qf[c], s0, 0, 0, 0); s1 = __builtin_amdgcn_mfma_f32_32x32x16_f16(kf1, qf[c], s1, 0, 0, 0); }
                    float mt = -INFINITY;
                    if (2 * T + 1 >= dtile) {
                        const int relb = qrow0 - 64 * T + r32 - 4 * hi;
#pragma unroll
                        for (int r = 0; r < 16; ++r) { const int rel = relb - crow_off(r); s0[r] = (rel >= 0) ? s0[r] : -INFINITY; s1[r] = (rel >= 32) ? s1[r] : -INFINITY; }
                    }
#pragma unroll
                    for (int r = 0; r < 16; ++r) mt = fmaxf(mt, fmaxf(s0[r], s1[r]));
                    mt = fmaxf(mt, __shfl_xor(mt, 32));
                    const float mn = fmaxf(m, mt * c1);
                    const float al = __builtin_amdgcn_exp2f(m - mn);
                    float ls = 0.f;
#pragma unroll
                    for (int r = 0; r < 16; ++r) { s0[r] = __builtin_amdgcn_exp2f(fmaf(s0[r], c1, -mn)); s1[r] = __builtin_amdgcn_exp2f(fmaf(s1[r], c1, -mn)); ls += s0[r] + s1[r]; }
                    ls += __shfl_xor(ls, 32);
                    l = l * al + ls; m = mn;
                    if (__any(al != 1.f)) {
#pragma unroll
                        for (int r = 0; r < 16; ++r) { o[0][r] *= al; o[1][r] *= al; } }
                    h8 pk[4];
#pragma unroll
                    for (int e = 0; e < 8; ++e) { pk[0][e] = (_Float16)s0[e]; pk[1][e] = (_Float16)s0[8 + e]; pk[2][e] = (_Float16)s1[e]; pk[3][e] = (_Float16)s1[8 + e]; }
#pragma unroll
                    for (int d0 = 0; d0 < 2; ++d0)
#pragma unroll
                        for (int ks = 0; ks < 4; ++ks) {
                            LAS unsigned char* vp = bb + KBYTES + vrd_off + (16 * ks) * VP + d0 * 64;
                            const v4i16_t lo = __builtin_amdgcn_ds_read_tr16_b64_v4i16((LAS v4i16_t*)(vp));
                            const v4i16_t hh = __builtin_amdgcn_ds_read_tr16_b64_v4i16((LAS v4i16_t*)(vp + 8 * VP));
                            const h8 vf = __builtin_bit_cast(h8, __builtin_shufflevector(lo, hh, 0, 1, 2, 3, 4, 5, 6, 7));
                            o[d0] = __builtin_amdgcn_mfma_f32_32x32x16_f16(vf, pk[ks], o[d0], 0, 0, 0);
                        }
                }
}

__device__ __forceinline__ void mla_phase(const h16* Q2, const h16* KV, const h16* KR, h16* Y2, LAS unsigned char* lds, int G) {
    constexpr int KP = 208, VP = 144, KBYTES = 64 * KP, BUFB = KBYTES + 64 * VP;
    int tid = threadIdx.x; asm volatile("" : "+v"(tid));
    const int lane = tid & 63, w = __builtin_amdgcn_readfirstlane(tid >> 6), r32 = lane & 31, hi = lane >> 5;
    const float c1 = 0.10206207261596575f * LOG2E;
    const int krow = tid >> 3, kcc = tid & 7, rrow = tid >> 2, rcc = tid & 3;
    const int q4 = (lane & 15) >> 2, p4 = lane & 3, dblk = (lane >> 4) & 1;
    const int vrd_off = (4 * hi + q4) * VP + dblk * 32 + p4 * 8;
    for (int slot = ((gridDim.x % 8 == 0) ? (int)((blockIdx.x % 8) * (gridDim.x / 8) + blockIdx.x / 8) : (int)blockIdx.x); slot < 256; slot += G) {
        for (int ui = 0; ui < 4; ++ui) {
            const int bh = 2 * (slot >> 2) + (ui >> 1), u = (ui & 1) ? 7 - (slot & 3) : (slot & 3);
            const int b = bh >> 4, h = bh & 15;
            const h16* kbase = KV + (size_t)(b * SEQ) * UKV_N + h * 128;
            const h16* rbase = KR + (size_t)(b * SEQ) * 32;
            const int qrow0 = 256 * u + 32 * w, dtile = 8 * u + w;
            h8 qf[6];
            { const h16* qp = Q2 + (size_t)(b * SEQ + qrow0 + r32) * UQ_N + h * 96 + 8 * hi;
#pragma unroll
              for (int c = 0; c < 6; ++c) qf[c] = *(const h8*)(qp + 16 * c); }
            f32x16 o[2];
#pragma unroll
            for (int r = 0; r < 16; ++r) { o[0][r] = 0.f; o[1][r] = 0.f; }
            float m = -INFINITY, l = 0.f;
            u32x4 skA, svA, srA = {0u, 0u, 0u, 0u}, skB, svB, srB = {0u, 0u, 0u, 0u};
#define MLA_LOAD(SK, SV, SR, T_) do { const int tt_ = (T_) > 0 ? (T_) : 0; const size_t rr_ = (size_t)(64 * tt_ + krow); SK = *(const u32x4*)(kbase + rr_ * UKV_N + 8 * kcc); SV = *(const u32x4*)(kbase + rr_ * UKV_N + 64 + 8 * kcc); \
                if (tid < 256) SR = *(const u32x4*)(rbase + (size_t)(64 * tt_ + rrow) * 32 + 8 * rcc); } while (0)
#define MLA_STORE(SK, SV, SR, buf_) do { LAS unsigned char* bb_ = lds + (buf_) * BUFB; *(LAS u32x4*)(bb_ + krow * KP + kcc * 16) = SK; *(LAS u32x4*)(bb_ + KBYTES + krow * VP + kcc * 16) = SV; \
                if (tid < 256) *(LAS u32x4*)(bb_ + rrow * KP + 128 + rcc * 16) = SR; } while (0)
#define MLA_BAR() asm volatile("s_waitcnt lgkmcnt(0)\n\ts_barrier" ::: "memory")
            int T = 4 * u + 3;
            MLA_LOAD(skA, svA, srA, T); MLA_STORE(skA, svA, srA, 0);
            MLA_LOAD(skA, svA, srA, T - 1); MLA_LOAD(skB, svB, srB, T - 2);
            MLA_BAR();
            for (; T >= 0; T -= 2) {
                if (2 * T <= dtile) mla_tile(lds, T, dtile, qrow0, r32, hi, vrd_off, c1, qf, o, m, l);
                MLA_STORE(skA, svA, srA, 1);
                MLA_LOAD(skA, svA, srA, T - 3);
                MLA_BAR();
                if (2 * (T - 1) <= dtile) mla_tile(lds + BUFB, T - 1, dtile, qrow0, r32, hi, vrd_off, c1, qf, o, m, l);
                MLA_STORE(skB, svB, srB, 0);
                MLA_LOAD(skB, svB, srB, T - 4);
                MLA_BAR();
            }
#undef MLA_BAR
#undef MLA_LOAD
#undef MLA_STORE
            const float inv = 1.f / l;
#pragma unroll
            for (int r = 0; r < 16; ++r) { o[0][r] *= inv; o[1][r] *= inv; }
            store_o16(o, Y2 + (size_t)(b * SEQ + qrow0 + r32) * DM + 1024 + h * 64, hi);
        }
    }
}

#define XB_TMO      128
#define XB_XCNT(j)  (256  + 64 * (j))
#define XB_XSUB(j)  (1280 + 64 * (j))
#define XB_XGEN(j)  (2304 + 64 * (j))
#define XB_TOP      3328
#define XB_TOPGEN   3392
#define XCD_BAR_WORDS 3456
#define XB_SPIN_CAP (1u << 18)

__device__ __forceinline__ unsigned xb_ld(unsigned* p)              { return __hip_atomic_load(p, __ATOMIC_RELAXED, __HIP_MEMORY_SCOPE_AGENT); }
__device__ __forceinline__ unsigned xb_add(unsigned* p, unsigned v) { return __hip_atomic_fetch_add(p, v, __ATOMIC_RELAXED, __HIP_MEMORY_SCOPE_AGENT); }
__device__ __forceinline__ unsigned xb_xcc_id() { return (unsigned)__builtin_amdgcn_s_getreg((3 << 11) | 20) & 0xFu; }
#define XB_SPIN(cond, bar) do { unsigned _sp = 0; while (cond) { __builtin_amdgcn_s_sleep(1); \
    if ((++_sp & 255u) == 0u) { if (xb_ld(&(bar)[XB_TMO])) break; if (_sp > XB_SPIN_CAP) { atomicAdd(&(bar)[XB_TMO], 1u); break; } } } } while (0)

struct XcdBarrier {
    unsigned* bar; unsigned x;
    volatile LAS unsigned* st;
};

__device__ __forceinline__ XcdBarrier xcd_barrier_post(unsigned* bar, volatile LAS unsigned* st) {
    XcdBarrier b; b.bar = bar; b.x = xb_xcc_id(); b.st = st;
    if (threadIdx.x == 0) (void)xb_add(&bar[XB_XCNT(b.x)], 1u);
    return b;
}
__device__ __forceinline__ void xcd_barrier_complete(unsigned* bar, unsigned x, unsigned& nloc, unsigned& nx) {
    const unsigned G = gridDim.x * gridDim.y * gridDim.z;
    unsigned sum, cnt, mine, sp = 0u;
    for (;;) {
        sum = 0u; cnt = 0u; mine = 0u;
#pragma unroll
        for (unsigned j = 0; j < 16; ++j) { const unsigned c = xb_ld(&bar[XB_XCNT(j)]); sum += c; cnt += (c > 0u) ? 1u : 0u; mine = (j == x) ? c : mine; }
        if (sum == G) break;
        __builtin_amdgcn_s_sleep(1);
        if ((++sp & 255u) == 0u) { if (xb_ld(&bar[XB_TMO])) break; if (sp > XB_SPIN_CAP) { atomicAdd(&bar[XB_TMO], 1u); break; } }
    }
    nloc = mine > 0u ? mine : 1u; nx = cnt > 0u ? cnt : 1u;
}

__device__ __forceinline__ void xcd_barrier(const XcdBarrier& b) {
    asm volatile("s_waitcnt vmcnt(0)" ::: "memory");
    __syncthreads();
    if (threadIdx.x == 0) {
        unsigned* bar = b.bar;
        __builtin_amdgcn_s_waitcnt(0);
        unsigned nloc = b.st[0], nx = b.st[1];
        if (nloc == 0u) { xcd_barrier_complete(bar, b.x, nloc, nx); b.st[0] = nloc; b.st[1] = nx; }
        const unsigned old = xb_add(&bar[XB_XSUB(b.x)], 1u);
        const unsigned gen = old / nloc;
        if (old + 1u == (gen + 1u) * nloc) {
            __builtin_amdgcn_fence(__ATOMIC_RELEASE, "agent");
            asm volatile("s_waitcnt vmcnt(0)" ::: "memory");
            const unsigned og = xb_add(&bar[XB_TOP], 1u);
            const unsigned tg = og / nx;
            if (og + 1u == (tg + 1u) * nx) xb_add(&bar[XB_TOPGEN], 1u);
            else XB_SPIN(xb_ld(&bar[XB_TOPGEN]) == tg, bar);
            __builtin_amdgcn_fence(__ATOMIC_ACQUIRE, "agent");
            xb_add(&bar[XB_XGEN(b.x)], 1u);
            asm volatile("s_waitcnt vmcnt(0)" ::: "memory");
        } else {
            XB_SPIN(xb_ld(&bar[XB_XGEN(b.x)]) == gen, bar);
            __builtin_amdgcn_fence(__ATOMIC_ACQUIRE, "agent");
            asm volatile("s_waitcnt vmcnt(0)" ::: "memory");
        }
    }
    __syncthreads();
}

__global__ void __launch_bounds__(NWAVES * 64, 2) mega_fwd(Params P) {
    extern __shared__ __attribute__((aligned(16))) unsigned char lds_raw[];
    cg::grid_group grid = cg::this_grid();
    LAS unsigned char* lds = (LAS unsigned char*)lds_raw;
    const int G = gridDim.x, NGW = G * NWAVES; const long NGT = (long)G * (NWAVES * 64);
    volatile LAS unsigned* MISC = (volatile LAS unsigned*)(lds + 131072 + 512);
    if (threadIdx.x < 8) MISC[threadIdx.x] = 0u;
    __syncthreads();
    const XcdBarrier bar = xcd_barrier_post((unsigned*)(P.ws + WS_BAR), MISC);
    if (P.ws == nullptr) grid.sync();
#define TID_SETUP int tid = threadIdx.x; asm volatile("" : "+v"(tid)); const int lane = tid & 63, wave = __builtin_amdgcn_readfirstlane(tid >> 6); \
    const int vcu_ = (gridDim.x % 8 == 0) ? (int)((blockIdx.x % 8) * (gridDim.x / 8) + blockIdx.x / 8) : (int)blockIdx.x;     \
    const int gw = vcu_ * NWAVES + wave; const long gt = (long)blockIdx.x * (NWAVES * 64) + tid; LAS unsigned char* wlds = lds + wave * 16384; (void)gt; (void)gw; (void)lane; (void)wlds;
#define WS_SETUP unsigned char* ws = P.ws; asm volatile("" : "+s"(ws)); float* R = P.out; asm volatile("" : "+s"(R)); (void)R;
#define x_in (P.in[0])
#define XB ((h16*)(ws + WS_XB))
#define HID ((h16*)(ws + WS_HID))
#define H ((h16*)(ws + WS_H))
#define Y ((h16*)(ws + WS_Y))
#define H2 ((h16*)(ws + WS_H2))
#define CQN ((h16*)(ws + WS_CQN))
#define CKVN ((h16*)(ws + WS_CKVN))
#define KR ((h16*)(ws + WS_KR))
#define Q2 ((h16*)(ws + WS_Q2))
#define KV ((h16*)(ws + WS_KV))
#define Y2 ((h16*)(ws + WS_Y2))
#define ROPE ((float*)(ws + WS_ROPE))
#define STATS ((float*)(ws + WS_STATS))
#define C1 ((float*)(ws + WS_C12))
#define C2 (C1 + 20480)
#define PO ((h16*)R)
#define LSE (R + OUT_LSE)
#define XR ((h16*)R)

    { WS_SETUP TID_SETUP
            LAS float* scr = (LAS float*)wlds;
            for (long i = gt; i < (long)(3 * MTOK * 2 + 2 * 20480) / 4; i += NGT) { f32x4* z = (i < 3 * MTOK * 2 / 4) ? (f32x4*)STATS + i : (f32x4*)C1 + (i - 3 * MTOK * 2 / 4); *z = (f32x4){0.f, 0.f, 0.f, 0.f}; }
            for (int wi = 0; wi < 10; ++wi) {
                if (wi == 2 || wi == 4 || wi == 8) continue;
                const float* W; int K, N; size_t dst;
                switch (wi) {
                    case 0: W = P.in[1]; K = DM; N = EVEN_IN; dst = WS_W_EIN; break;
                    case 1: W = P.in[3]; K = EVEN_OUT; N = DM; dst = WS_W_EOUT; break;
                    case 2: W = P.in[12]; K = DM; N = DFF; dst = WS_W_W1A; break;
                    case 3: W = P.in[13]; K = DFF; N = DM; dst = WS_W_W2A; break;
                    case 4: W = P.in[4]; K = DM; N = ODD_IN; dst = WS_W_OIN; break;
                    case 5: W = P.in[7]; K = 512; N = UQ_N; dst = WS_W_UQ; break;
                    case 6: W = P.in[8]; K = 256; N = UKV_N; dst = WS_W_UKV; break;
                    case 7: W = P.in[9]; K = DM; N = DM; dst = WS_W_OOUT; break;
                    case 8: W = P.in[12] + (size_t)DM * DFF; K = DM; N = DFF; dst = WS_W_W1B; break;
                    default: W = P.in[13] + (size_t)DM * DFF; K = DFF; N = DM; dst = WS_W_W2B; break;
                }
                const int nitems = (K / 64) * (N / 32);
                for (int it = gw; it < nitems; it += NGW) transpose_item(W, K, N, (h16*)(ws + dst), it, scr, lane);
            }
            {
                u32x4* z = (u32x4*)(ws + WS_W_OIN + (size_t)ODD_IN * DM * 2); const long n16 = (long)(ODD_INP - ODD_IN) * DM * 2 / 16;
                for (long i = gt; i < n16; i += NGT) z[i] = (u32x4){0u, 0u, 0u, 0u}; }
            {
                const long n8 = (long)MTOK * DM / 8;
                for (long i = gt; i < n8; i += 4 * NGT) {
                    f32x4 a[4], b[4];
#pragma unroll
                    for (int j = 0; j < 4; ++j) { const long ii = i + j * NGT; if (ii < n8) { a[j] = ((const f32x4*)x_in)[2 * ii]; b[j] = ((const f32x4*)x_in)[2 * ii + 1]; } }
#pragma unroll
                    for (int j = 0; j < 4; ++j) { const long ii = i + j * NGT; if (ii < n8) { u32x4 w; w.x = pk16(a[j].x, a[j].y); w.y = pk16(a[j].z, a[j].w); w.z = pk16(b[j].x, b[j].y); w.w = pk16(b[j].z, b[j].w); ((u32x4*)XB)[ii] = w; } } } }
            for (long i = gt; i < SEQ * 16; i += NGT) { const int pos = (int)(i >> 4), fi = (int)(i & 15);
                double invd = 1.0; for (int e = 0; e < fi; ++e) invd *= 0.56234132519034907;
                const float inv = (float)invd;
                const float ang = (float)pos * inv; double s, c; sincos_d((double)ang, s, c);
                ROPE[pos * 32 + fi] = (float)c; ROPE[pos * 32 + 16 + fi] = (float)s; }
    }
    xcd_barrier(bar);
    { WS_SETUP pg8::Gemm g{XB, (const h16*)(ws + WS_W_EIN), MTOK, EVEN_IN, DM}; pg8::EpiAny<0, 0> E{}; E.O = H; E.ldc = EVEN_IN;
      pg8::StaticOrder S; S.init(MTOK, EVEN_IN, G, (int)blockIdx.x, WGM_IN);
      pg8::gemm_phase<pg8::EpiAny<0, 0>, pg8::StaticOrder, true, true>(lds, g, S, E); }
    xcd_barrier(bar);
    { WS_SETUP TID_SETUP
            ab_phase(H, P.in[2], Y, PO, LSE, lds, G);
    }
    xcd_barrier(bar);
    { WS_SETUP TID_SETUP
            for (long i = gt; i < (long)MTOK * 128; i += NGT) { const size_t tok = (size_t)(i >> 7); const int h = (int)((i >> 4) & 7), dg = (int)(i & 15);
                const float l0 = LSE[tok * 8 + h], l1 = LSE[((size_t)MTOK + tok) * 8 + h], l2 = LSE[((size_t)2 * MTOK + tok) * 8 + h];
                const float mx = fmaxf(l0, fmaxf(l1, l2)); const float w0 = __expf(l0 - mx), w1 = __expf(l1 - mx), w2 = __expf(l2 - mx); const float iw = 1.f / (w0 + w1 + w2);
                const size_t po = tok * 512 + h * 64 + dg * 4;
                const h4 q0 = __builtin_nontemporal_load((const h4*)(PO + po)), q1 = __builtin_nontemporal_load((const h4*)(PO + (size_t)MTOK * 512 + po)), q2 = __builtin_nontemporal_load((const h4*)(PO + (size_t)2 * MTOK * 512 + po));
                const f32x4 a0 = {(float)q0[0], (float)q0[1], (float)q0[2], (float)q0[3]}, a1 = {(float)q1[0], (float)q1[1], (float)q1[2], (float)q1[3]}, a2 = {(float)q2[0], (float)q2[1], (float)q2[2], (float)q2[3]};
                const f32x4 r = (a0 * w0 + a1 * w1 + a2 * w2) * iw;
                u32x2 w; w.x = pk16(r.x, r.y); w.y = pk16(r.z, r.w); *(u32x2*)(Y + tok * EVEN_OUT + 1024 + h * 64 + dg * 4) = w; }
            { LAS float* scr = (LAS float*)wlds;
              for (int wi = 0; wi < 3; ++wi) {
                const float* W = (wi == 0) ? P.in[12] : (wi == 1) ? P.in[4] : P.in[12] + (size_t)DM * DFF;
                const int N = (wi == 1) ? ODD_IN : DFF; const size_t dst = (wi == 0) ? WS_W_W1A : (wi == 1) ? WS_W_OIN : WS_W_W1B;
                const float* gg = (wi == 0) ? P.in[10] : (wi == 1) ? P.in[14] : P.in[10] + DM; const float* bb = (wi == 0) ? P.in[11] : (wi == 1) ? P.in[15] : P.in[11] + DM;
                const int coff = (wi == 0) ? 0 : (wi == 1) ? 8192 : 12288;
                const int nitems = (DM / 64) * (N / 32);
                for (int it = gw; it < nitems; it += NGW) transpose_item_fold(W, DM, N, (h16*)(ws + dst), it, scr, lane, gg, bb, C1 + coff, C2 + coff);
              } }
    }
    xcd_barrier(bar);
    { WS_SETUP pg8::Gemm g{Y, (const h16*)(ws + WS_W_EOUT), MTOK, DM, EVEN_OUT}; pg8::EpiAny<2, 0> E{}; E.xbase = XB  ; E.ldc = DM; E.alpha = ALPHA; E.xb = XB; E.st_out = STATS;
      pg8::StaticOrder S; S.init(MTOK, DM, G, (int)blockIdx.x, WGM_N2048);
      pg8::gemm_phase<pg8::EpiAny<2, 0>, pg8::StaticOrder, true, true>(lds, g, S, E); }
    xcd_barrier(bar);
    { WS_SETUP pg8::Gemm g{XB, (const h16*)(ws + WS_W_W1A), MTOK, DFF, DM}; pg8::EpiAny<1, 1> E{}; E.O = HID; E.ldc = DFF; E.st_in = STATS; E.c1 = C1; E.c2 = C2;
      pg8::StaticOrder S; S.init(MTOK, DFF, G, (int)blockIdx.x, WGM_UP);
      pg8::gemm_phase<pg8::EpiAny<1, 1>, pg8::StaticOrder, true, true>(lds, g, S, E); }
    xcd_barrier(bar);
    { WS_SETUP pg8::Gemm g{HID, (const h16*)(ws + WS_W_W2A), MTOK, DM, DFF}; pg8::EpiAny<2, 1> E{}; E.xbase = XB; E.ldc = DM; E.alpha = ALPHA; E.st_in = STATS; E.g = P.in[10]; E.b = P.in[11]; E.xb = XR; E.st_out = STATS + 2 * MTOK;
      pg8::StaticOrder S; S.init(MTOK, DM, G, (int)blockIdx.x, WGM_N2048, 4);
      pg8::gemm_phase<pg8::EpiAny<2, 1>, pg8::StaticOrder, true, true>(lds, g, S, E); }
    xcd_barrier(bar);
    { WS_SETUP pg8::Gemm g{XR, (const h16*)(ws + WS_W_OIN), MTOK, ODD_INP, DM}; pg8::EpiAny<0, 1> E{}; E.O = H2; E.ldc = ODD_INP; E.st_in = STATS + 2 * MTOK; E.c1 = C1 + 8192; E.c2 = C2 + 8192;
      pg8::StaticOrder S; S.init(MTOK, ODD_INP, G, (int)blockIdx.x, WGM_IN);
      pg8::gemm_phase<pg8::EpiAny<0, 1>, pg8::StaticOrder, true, true>(lds, g, S, E); }
    xcd_barrier(bar);
    { WS_SETUP TID_SETUP
            const float* gq = P.in[5]; const float* gkv = P.in[6];
            for (int row = gw; row < MTOK; row += NGW) {
                const h16* hp = H2 + (size_t)row * ODD_INP;
                const h8 cq = *(const h8*)(hp + 3072 + 8 * lane); const h4 ck = *(const h4*)(hp + 3584 + 4 * lane);
                float xq[8], xk[4], sq = 0.f, sk = 0.f;
#pragma unroll
                for (int e = 0; e < 8; ++e) { xq[e] = (float)cq[e]; sq += xq[e] * xq[e]; }
#pragma unroll
                for (int e = 0; e < 4; ++e) { xk[e] = (float)ck[e]; sk += xk[e] * xk[e]; }
                const float rq = 1.f / sqrtf(wave_sum(sq) * (1.f / 512.f) + RMS_EPS), rk = 1.f / sqrtf(wave_sum(sk) * (1.f / 256.f) + RMS_EPS);
                const f32x4 g0 = *(const f32x4*)(gq + 8 * lane), g1 = *(const f32x4*)(gq + 8 * lane + 4), g2 = *(const f32x4*)(gkv + 4 * lane);
                u32x4 wq; wq.x = pk16(xq[0] * rq * g0.x, xq[1] * rq * g0.y); wq.y = pk16(xq[2] * rq * g0.z, xq[3] * rq * g0.w);
                wq.z = pk16(xq[4] * rq * g1.x, xq[5] * rq * g1.y); wq.w = pk16(xq[6] * rq * g1.z, xq[7] * rq * g1.w);
                *(u32x4*)(CQN + (size_t)row * 512 + 8 * lane) = wq;
                u32x2 wk; wk.x = pk16(xk[0] * rk * g2.x, xk[1] * rk * g2.y); wk.y = pk16(xk[2] * rk * g2.z, xk[3] * rk * g2.w);
                *(u32x2*)(CKVN + (size_t)row * 256 + 4 * lane) = wk;
                if (lane < 16) { const int pos = row & (SEQ - 1);
                    const float x1 = (float)*(const _Float16*)(hp + 3840 + lane), x2 = (float)*(const _Float16*)(hp + 3856 + lane);
                    const float c = ROPE[pos * 32 + lane], s = ROPE[pos * 32 + 16 + lane];
                    *(_Float16*)(KR + (size_t)row * 32 + lane) = (_Float16)(x1 * c - x2 * s);
                    *(_Float16*)(KR + (size_t)row * 32 + 16 + lane) = (_Float16)(x1 * s + x2 * c); }
            }
    }
    xcd_barrier(bar);
    { WS_SETUP pg8::Gemm g{CQN, (const h16*)(ws + WS_W_UQ), MTOK, UQ_N, 512}; pg8::EpiAny<3, 0> E{}; E.O = Q2; E.ldc = UQ_N; E.rope = ROPE;
      pg8::StaticOrder S; S.init(MTOK, UQ_N, G, (int)blockIdx.x, WGM_SMALL);
      pg8::gemm_phase<pg8::EpiAny<3, 0>, pg8::StaticOrder, true, true>(lds, g, S, E); }
    { WS_SETUP pg8::Gemm g{CKVN, (const h16*)(ws + WS_W_UKV), MTOK, UKV_N, 256}; pg8::EpiAny<0, 0> E{}; E.O = KV; E.ldc = UKV_N;
      pg8::StaticOrder S; S.init(MTOK, UKV_N, G, (int)blockIdx.x, WGM_SMALL);
      pg8::gemm_phase<pg8::EpiAny<0, 0>, pg8::StaticOrder, true, true>(lds, g, S, E); }
    xcd_barrier(bar);
    { WS_SETUP TID_SETUP
            for (int T = gw; T < 8192; T += NGW) {
                const int b = T >> 10, h = (T >> 6) & 15, qb = T & 63;
                AttnArgs a; f32x16 o[2]; float lse2;
                a.q0 = qb * 32; a.kt_hi = qb; a.kt_lo = 0; a.rmax = 1 << 30; a.slope2 = 0.f; a.sink2 = -INFINITY;
                const h16* base = H2 + (size_t)(b * SEQ) * ODD_INP + h * 64;
                a.q = base; a.k = base + 1024; a.v = base + 2048; a.qstride = a.kstride = a.vstride = ODD_INP; a.k2 = nullptr; a.k2stride = 0; a.c1 = 0.125f;
                attn_task<4, true>(a, wlds, lane, o, lse2);
                store_o16(o, Y2 + (size_t)(b * SEQ + a.q0 + (lane & 31)) * DM + h * 64, lane >> 5);
            }
            __syncthreads();
            mla_phase(Q2, KV, KR, Y2, lds, G);
    }
    xcd_barrier(bar);
    { WS_SETUP pg8::Gemm g{Y2, (const h16*)(ws + WS_W_OOUT), MTOK, DM, DM}; pg8::EpiAny<2, 1> E{}; E.xbase = XR; E.ldc = DM; E.alpha = ALPHA; E.st_in = STATS + 2 * MTOK; E.g = P.in[14]; E.b = P.in[15]; E.xb = KV  ; E.st_out = STATS + 4 * MTOK;
      pg8::StaticOrder S; S.init(MTOK, DM, G, (int)blockIdx.x, WGM_N2048);
      pg8::gemm_phase<pg8::EpiAny<2, 1>, pg8::StaticOrder, true, true>(lds, g, S, E); }
    xcd_barrier(bar);
    { WS_SETUP pg8::Gemm g{KV, (const h16*)(ws + WS_W_W1B), MTOK, DFF, DM}; pg8::EpiAny<1, 1> E{}; E.O = HID; E.ldc = DFF; E.st_in = STATS + 4 * MTOK; E.c1 = C1 + 12288; E.c2 = C2 + 12288;
      pg8::StaticOrder S; S.init(MTOK, DFF, G, (int)blockIdx.x, WGM_UP);
      pg8::gemm_phase<pg8::EpiAny<1, 1>, pg8::StaticOrder, true, true>(lds, g, S, E); }
    xcd_barrier(bar);
    { WS_SETUP pg8::Gemm g{HID, (const h16*)(ws + WS_W_W2B), MTOK, DM, DFF}; pg8::EpiAny<2, 3> E{}; E.xbase = KV; E.xb = XB  ; E.ldc = DM; E.alpha = ALPHA; E.st_in = STATS + 4 * MTOK; E.g = P.in[10] + DM; E.b = P.in[11] + DM;
      pg8::StaticOrder S; S.init(MTOK, DM, G, (int)blockIdx.x, WGM_N2048, 4);
      pg8::gemm_phase<pg8::EpiAny<2, 3>, pg8::StaticOrder, true, true>(lds, g, S, E); }
    xcd_barrier(bar);
    { WS_SETUP TID_SETUP ln_final(XB, R, P.in[14] + 1 * DM, P.in[15] + 1 * DM, gw, NGW, lane); }
}

#undef x_in
#undef XB
#undef HID
#undef H
#undef Y
#undef H2
#undef CQN
#undef CKVN
#undef KR
#undef Q2
#undef KV
#undef Y2
#undef ROPE
#undef STATS
#undef C1
#undef C2
#undef PO
#undef LSE
#undef XR
extern "C" void kernel_launch(void* const* d_in, const int* in_sizes, int n_in, void* d_out, int out_size, void* d_ws, size_t ws_size, hipStream_t stream) {
    constexpr int LDS_BYTES = 147456;
    static int grid = 0;
    if (grid == 0) {
        if (n_in != 16 || in_sizes[0] != MTOK * DM || out_size != MTOK * DM || ws_size < WS_END) {
            fprintf(stderr, "kernel_launch: unexpected shapes: n_in %d in0 %d out %d ws %zu (need %zu)\n", n_in, n_in > 0 ? in_sizes[0] : -1, out_size, ws_size, (size_t)WS_END); grid = -1; return; }
        int dev = 0, cus = 0, per_cu = 0;
        if (hipGetDevice(&dev) != hipSuccess || hipDeviceGetAttribute(&cus, hipDeviceAttributeMultiprocessorCount, dev) != hipSuccess) { grid = -1; return; }
        if (hipFuncSetAttribute((const void*)mega_fwd, hipFuncAttributeMaxDynamicSharedMemorySize, LDS_BYTES) != hipSuccess) { fprintf(stderr, "kernel_launch: hipFuncSetAttribute failed\n"); grid = -1; return; }
        if (hipOccupancyMaxActiveBlocksPerMultiprocessor(&per_cu, (const void*)mega_fwd, NWAVES * 64, LDS_BYTES) != hipSuccess || per_cu < 1) { fprintf(stderr, "kernel_launch: occupancy query says %d\n", per_cu); per_cu = 1; }
        (void)hipGetLastError();
        grid = cus * per_cu;
    }
    if (grid < 0) return;
    Params p{};
    for (int i = 0; i < 16; ++i) p.in[i] = (const float*)d_in[i];
    p.out = (float*)d_out; p.ws = (unsigned char*)d_ws;
    if (hipMemsetAsync((char*)d_ws + WS_BAR, 0, 16384, stream) != hipSuccess) { fprintf(stderr, "kernel_launch: memset of the barrier words failed\n"); return; }
    void* args[] = {&p};
    hipError_t e = hipLaunchCooperativeKernel((const void*)mega_fwd, dim3(grid), dim3(NWAVES * 64), args, LDS_BYTES, stream);
    if (e != hipSuccess) fprintf(stderr, "kernel_launch: cooperative launch failed: %s (grid %d)\n", hipGetErrorString(e), grid);
}
```
